# Optimizing an MI355X kernel written in HIP

```python
import math
import jax, jax.numpy as jnp
from jax import lax
import numpy as np

D_MODEL = 1024
BATCH = 4
SEQ = 4096
DEPTH = 1

NSA_HEADS = 8
NSA_GROUPS = 2
HEADS_PER_GROUP = NSA_HEADS // NSA_GROUPS
HEAD_DIM = 64
NSA_WIDTH = NSA_HEADS * HEAD_DIM
KV_WIDTH = NSA_GROUPS * HEAD_DIM
CMP_BLOCK = 32
CMP_STRIDE = 16
CMP_HIDDEN = 256
SEL_BLOCK = 64
SEL_TOPK = 16
WINDOW = 512
Q_BLOCK = 64
ROPE_THETA = 10000.0
FORCED_SCORE = 1.0e4
NEG = -1.0e30
S5_WIDTH = D_MODEL // 2
S5_GROUP = 16
S5_GROUPS = S5_WIDTH // S5_GROUP
S5_STATE = 64
DT_MIN = 1.0e-3
DT_MAX = 1.0e-1
N_BRANCHES = 2
RMS_EPS = 1.0e-6
D_IN = NSA_WIDTH + 6 * KV_WIDTH + 3 * NSA_HEADS + NSA_WIDTH + 2 * S5_WIDTH + N_BRANCHES * D_MODEL

kernel_name = "hybrid_nsa_s5_gated_block"


def _split_points():
    sizes = [NSA_WIDTH] + [KV_WIDTH] * 6 + [3 * NSA_HEADS, NSA_WIDTH, S5_WIDTH, S5_WIDTH]
    pts, acc = [], 0
    for s in sizes:
        acc += s
        pts.append(acc)
    return pts


def rmsnorm(x, g):
    xf = x.astype(jnp.float32)
    y = xf * lax.rsqrt(jnp.mean(xf * xf, axis=-1, keepdims=True) + RMS_EPS)
    return (y * g.astype(jnp.float32)).astype(x.dtype)


def rope(t, pos):
    half = t.shape[-1] // 2
    inv_freq = ROPE_THETA ** (-jnp.arange(half, dtype=jnp.float32) / half)
    ang = pos.astype(jnp.float32)[:, None] * inv_freq[None, :]
    shp = (1, t.shape[1]) + (1,) * (t.ndim - 3) + (half,)
    cos = jnp.cos(ang).reshape(shp).astype(t.dtype)
    sin = jnp.sin(ang).reshape(shp).astype(t.dtype)
    t1, t2 = t[..., :half], t[..., half:]
    return jnp.concatenate([t1 * cos - t2 * sin, t2 * cos + t1 * sin], axis=-1)


def masked_softmax(s, mask):
    s = jnp.where(mask, s.astype(jnp.float32), NEG)
    m = jnp.max(s, axis=-1, keepdims=True)
    e = jnp.exp(s - m) * mask
    return e / jnp.maximum(jnp.sum(e, axis=-1, keepdims=True), 1.0e-30)


def compress(kv, pos_emb, w1, w2):
    B, T, G, dh = kv.shape
    chunks = kv.reshape(B, T // CMP_STRIDE, CMP_STRIDE, G, dh)
    blocks = jnp.concatenate([chunks[:, :-1], chunks[:, 1:]], axis=2)
    blocks = blocks + pos_emb[None, None, :, None, :]
    flat = jnp.moveaxis(blocks, 3, 2).reshape(B, blocks.shape[1], G, CMP_BLOCK * dh)
    return jax.nn.gelu(flat @ w1) @ w2


def s5_scan(u, lam_re, lam_im, log_dt, b_re, b_im, c_re, c_im, d):
    B, T, _ = u.shape
    f32 = jnp.float32
    lam_re, lam_im = lam_re.astype(f32), lam_im.astype(f32)
    dt = jnp.exp(log_dt.astype(f32))[:, None]
    mag = jnp.exp(lam_re * dt)
    a_re, a_im = mag * jnp.cos(lam_im * dt), mag * jnp.sin(lam_im * dt)
    den = lam_re * lam_re + lam_im * lam_im
    z_re = ((a_re - 1.0) * lam_re + a_im * lam_im) / den
    z_im = (a_im * lam_re - (a_re - 1.0) * lam_im) / den
    b_re, b_im = b_re.astype(f32), b_im.astype(f32)
    bb_re = z_re[..., None] * b_re - z_im[..., None] * b_im
    bb_im = z_re[..., None] * b_im + z_im[..., None] * b_re
    ug = u.astype(f32).reshape(B, T, S5_GROUPS, S5_GROUP)
    bu_re = jnp.einsum('btgc,gpc->btgp', ug, bb_re)
    bu_im = jnp.einsum('btgc,gpc->btgp', ug, bb_im)
    ar = jnp.broadcast_to(a_re, bu_re.shape)
    ai = jnp.broadcast_to(a_im, bu_im.shape)

    def combine(e1, e2):
        a1r, a1i, b1r, b1i = e1
        a2r, a2i, b2r, b2i = e2
        return (a2r * a1r - a2i * a1i,
                a2r * a1i + a2i * a1r,
                a2r * b1r - a2i * b1i + b2r,
                a2r * b1i + a2i * b1r + b2i)

    _, _, xr, xi = lax.associative_scan(combine, (ar, ai, bu_re, bu_im), axis=1)
    y = jnp.einsum('btgp,gcp->btgc', xr, c_re.astype(f32)) - jnp.einsum('btgp,gcp->btgc', xi, c_im.astype(f32))
    y = y.reshape(B, T, S5_WIDTH) + d.astype(f32) * u.astype(f32)
    return y.astype(u.dtype)


def setup_inputs(seed: int = 0) -> dict:
    key = jax.random.key(seed)
    ks = jax.random.split(key, 24)
    nrm = jax.random.normal
    L = DEPTH
    n = jnp.arange(S5_STATE, dtype=jnp.float32)
    log_lo, log_hi = math.log(DT_MIN), math.log(DT_MAX)
    return {
        "x": nrm(ks[0], (BATCH, SEQ, D_MODEL), jnp.float32),
        "norm_g": 1.0 + 0.02 * nrm(ks[1], (L, D_MODEL), jnp.float32),
        "w_in": nrm(ks[2], (L, D_MODEL, D_IN), jnp.float32) * D_MODEL ** -0.5,
        "cmp_pos_k": 0.1 * nrm(ks[3], (L, CMP_BLOCK, HEAD_DIM), jnp.float32),
        "cmp_pos_v": 0.1 * nrm(ks[4], (L, CMP_BLOCK, HEAD_DIM), jnp.float32),
        "cmp_w1_k": nrm(ks[5], (L, CMP_BLOCK * HEAD_DIM, CMP_HIDDEN), jnp.float32) * (CMP_BLOCK * HEAD_DIM) ** -0.5,
        "cmp_w2_k": nrm(ks[6], (L, CMP_HIDDEN, HEAD_DIM), jnp.float32) * CMP_HIDDEN ** -0.5,
        "cmp_w1_v": nrm(ks[7], (L, CMP_BLOCK * HEAD_DIM, CMP_HIDDEN), jnp.float32) * (CMP_BLOCK * HEAD_DIM) ** -0.5,
        "cmp_w2_v": nrm(ks[8], (L, CMP_HIDDEN, HEAD_DIM), jnp.float32) * CMP_HIDDEN ** -0.5,
        "s5_lam_re": -0.5 + 0.01 * nrm(ks[9], (L, S5_GROUPS, S5_STATE), jnp.float32),
        "s5_lam_im": math.pi * n + 0.01 * nrm(ks[10], (L, S5_GROUPS, S5_STATE), jnp.float32),
        "s5_log_dt": jax.random.uniform(ks[11], (L, S5_GROUPS), jnp.float32, log_lo, log_hi),
        "s5_b_re": nrm(ks[12], (L, S5_GROUPS, S5_STATE, S5_GROUP), jnp.float32) * (2 * S5_GROUP) ** -0.5,
        "s5_b_im": nrm(ks[13], (L, S5_GROUPS, S5_STATE, S5_GROUP), jnp.float32) * (2 * S5_GROUP) ** -0.5,
        "s5_c_re": nrm(ks[14], (L, S5_GROUPS, S5_GROUP, S5_STATE), jnp.float32) * S5_STATE ** -0.5,
        "s5_c_im": nrm(ks[15], (L, S5_GROUPS, S5_GROUP, S5_STATE), jnp.float32) * S5_STATE ** -0.5,
        "s5_d": nrm(ks[16], (L, S5_WIDTH), jnp.float32),
        "w_glu": nrm(ks[17], (L, S5_WIDTH, S5_WIDTH), jnp.float32) * S5_WIDTH ** -0.5,
        "b_glu": 0.01 * nrm(ks[18], (L, S5_WIDTH), jnp.float32),
        "w_proj_nsa": nrm(ks[19], (L, NSA_WIDTH, D_MODEL), jnp.float32) * NSA_WIDTH ** -0.5,
        "w_proj_s5": nrm(ks[20], (L, S5_WIDTH, D_MODEL), jnp.float32) * S5_WIDTH ** -0.5,
        "w_out": nrm(ks[21], (L, D_MODEL, D_MODEL), jnp.float32) * D_MODEL ** -0.5,
        "final_g": 1.0 + 0.02 * nrm(ks[22], (D_MODEL,), jnp.float32),
    }


def reference(x, norm_g, w_in, cmp_pos_k, cmp_pos_v, cmp_w1_k, cmp_w2_k, cmp_w1_v, cmp_w2_v,
              s5_lam_re, s5_lam_im, s5_log_dt, s5_b_re, s5_b_im, s5_c_re, s5_c_im, s5_d,
              w_glu, b_glu, w_proj_nsa, w_proj_s5, w_out, final_g):
    B, T, _ = x.shape
    G, R, dh = NSA_GROUPS, HEADS_PER_GROUP, HEAD_DIM
    NC = T // CMP_STRIDE - 1
    NS = T // SEL_BLOCK
    NQB = T // Q_BLOCK
    n_top = min(SEL_TOPK, NS)
    scale = HEAD_DIM ** -0.5
    pos = jnp.arange(T)

    c_start = jnp.arange(NC) * CMP_STRIDE
    s_start = jnp.arange(NS) * SEL_BLOCK
    overlap = ((c_start[:, None] < s_start[None, :] + SEL_BLOCK) &
               (c_start[:, None] + CMP_BLOCK > s_start[None, :])).astype(jnp.float32)
    cmp_end = c_start + CMP_BLOCK - 1
    blk = jnp.arange(NS)
    b_ix = jnp.arange(B)[:, None, None, None]
    g_ix = jnp.arange(G)[None, :, None, None]

    for l in range(DEPTH):
        h = rmsnorm(x, norm_g[l])
        proj = h @ w_in[l]
        (q, kc, vc, ksl, vsl, kwi, vwi, gl, gate_nsa, u, gate_s5, mg) = jnp.split(proj, _split_points(), axis=-1)

        q = q.reshape(B, T, G, R, dh)
        qr = rope(q, pos)
        kc, vc = kc.reshape(B, T, G, dh), vc.reshape(B, T, G, dh)
        k_cmp = compress(kc, cmp_pos_k[l], cmp_w1_k[l], cmp_w2_k[l])
        v_cmp = compress(vc, cmp_pos_v[l], cmp_w1_v[l], cmp_w2_v[l])
        ksl = rope(ksl.reshape(B, T, G, dh), pos)
        k_sel = ksl.reshape(B, NS, SEL_BLOCK, G, dh).transpose(0, 3, 1, 2, 4)
        v_sel = vsl.reshape(B, NS, SEL_BLOCK, G, dh).transpose(0, 3, 1, 2, 4)
        kwi = rope(kwi.reshape(B, T, G, dh), pos)
        k_win = jnp.pad(kwi, ((0, 0), (WINDOW, 0), (0, 0), (0, 0)))
        v_win = jnp.pad(vwi.reshape(B, T, G, dh), ((0, 0), (WINDOW, 0), (0, 0), (0, 0)))

        def nsa_block(args):
            qb, q_blk, qr_blk = args
            t = qb * Q_BLOCK + jnp.arange(Q_BLOCK)
            s_c = jnp.einsum('bqgrd,bcgd->bgrqc', q_blk, k_cmp) * scale
            p_cmp = masked_softmax(s_c, cmp_end[None, :] <= t[:, None])
            o_cmp = jnp.einsum('bgrqc,bcgd->bqgrd', p_cmp.astype(v_cmp.dtype), v_cmp)
            imp = jnp.einsum('bgrqc,cn->bgqn', p_cmp, overlap)
            cur = t // SEL_BLOCK
            forced = (blk[None] == 0) | (blk[None] == cur[:, None]) | (blk[None] == cur[:, None] - 1)
            causal_blk = blk[None] * SEL_BLOCK <= t[:, None]
            imp = jnp.where(forced, FORCED_SCORE, jnp.where(causal_blk, imp, -1.0))
            _, idx = lax.top_k(imp, n_top)
            kg = k_sel[b_ix, g_ix, idx]
            vg = v_sel[b_ix, g_ix, idx]
            s_s = jnp.einsum('bqgrd,bgqnkd->bgrqnk', qr_blk, kg) * scale
            kpos = idx[..., None] * SEL_BLOCK + jnp.arange(SEL_BLOCK)
            m_s = (kpos <= t[:, None, None]).reshape(B, G, 1, Q_BLOCK, n_top * SEL_BLOCK)
            p_s = masked_softmax(s_s.reshape(B, G, R, Q_BLOCK, n_top * SEL_BLOCK), m_s)
            o_sel = jnp.einsum('bgrqm,bgqmd->bqgrd', p_s.astype(vg.dtype),
                               vg.reshape(B, G, Q_BLOCK, n_top * SEL_BLOCK, dh))
            start = qb * Q_BLOCK
            kw = lax.dynamic_slice_in_dim(k_win, start, Q_BLOCK + WINDOW, axis=1)
            vw = lax.dynamic_slice_in_dim(v_win, start, Q_BLOCK + WINDOW, axis=1)
            wpos = start - WINDOW + jnp.arange(Q_BLOCK + WINDOW)
            m_w = (wpos[None] <= t[:, None]) & (wpos[None] > t[:, None] - WINDOW) & (wpos[None] >= 0)
            s_w = jnp.einsum('bqgrd,bkgd->bgrqk', qr_blk, kw) * scale
            p_w = masked_softmax(s_w, m_w)
            o_win = jnp.einsum('bgrqk,bkgd->bqgrd', p_w.astype(vw.dtype), vw)
            return (o_cmp, o_sel, o_win)

        q_blocks = q.reshape(B, NQB, Q_BLOCK, G, R, dh).swapaxes(0, 1)
        qr_blocks = qr.reshape(B, NQB, Q_BLOCK, G, R, dh).swapaxes(0, 1)
        o_c, o_s, o_w = lax.map(nsa_block, (jnp.arange(NQB), q_blocks, qr_blocks))
        unblock = lambda o: o.swapaxes(0, 1).reshape(B, T, G, R, dh)
        gates = jax.nn.sigmoid(gl.reshape(B, T, G, R, 3))
        o_nsa = (gates[..., 0:1] * unblock(o_c) + gates[..., 1:2] * unblock(o_s)
                 + gates[..., 2:3] * unblock(o_w)).reshape(B, T, NSA_WIDTH)
        branch_a = (o_nsa * jax.nn.silu(gate_nsa)) @ w_proj_nsa[l]

        y = s5_scan(u, s5_lam_re[l], s5_lam_im[l], s5_log_dt[l], s5_b_re[l], s5_b_im[l],
                    s5_c_re[l], s5_c_im[l], s5_d[l])
        z = jax.nn.gelu(y)
        o_s5 = z * jax.nn.sigmoid(z @ w_glu[l] + b_glu[l])
        branch_b = (o_s5 * jax.nn.silu(gate_s5)) @ w_proj_s5[l]

        mg_a, mg_b = jnp.split(mg, N_BRANCHES, axis=-1)
        merged = jax.nn.sigmoid(mg_a) * branch_a + jax.nn.sigmoid(mg_b) * branch_b
        x = x + merged @ w_out[l]

    return rmsnorm(x, final_g)
```

```cpp
#include <hip/hip_runtime.h>
#include <hip/hip_cooperative_groups.h>
#include <stdint.h>
#include <stdio.h>
namespace cg = cooperative_groups;

#ifndef PROBE_DUP
#define PROBE_DUP -1
#endif
#ifndef MULTI_LAUNCH
#define MULTI_LAUNCH 0
#endif

typedef unsigned short bf16_t;
typedef short bf16x8 __attribute__((ext_vector_type(8)));
typedef short bf16x4 __attribute__((ext_vector_type(4)));
typedef float f32x16 __attribute__((ext_vector_type(16)));
typedef float f32x4 __attribute__((ext_vector_type(4)));
typedef uint32_t u32x4 __attribute__((ext_vector_type(4)));
typedef f32x4 AccT[4][4];

constexpr int T_ = 4096, NT = 16384, DM = 1024;
constexpr int NTHR = 256;
constexpr size_t MB = 1u << 20;
constexpr size_t OFF_HN = 0;
constexpr size_t OFF_WINT = 32 * MB;
constexpr size_t OFF_GN = 42 * MB;
constexpr size_t OFF_U2 = 58 * MB;
constexpr size_t OFF_GS = 74 * MB;
constexpr size_t OFF_MGA = 90 * MB;
constexpr size_t OFF_MGB = 122 * MB;
constexpr size_t OFF_GL = 154 * MB;
constexpr size_t OFF_ONSA = 156 * MB;
constexpr size_t OFF_Z = 172 * MB;
constexpr size_t OFF_OS5 = 188 * MB;
constexpr size_t OFF_W1KT = 204 * MB;
constexpr size_t OFF_W1VT = 205 * MB;
constexpr size_t OFF_W2KT = 206 * MB;
constexpr size_t OFF_W2VT = 206 * MB + 65536;
constexpr size_t OFF_BIAS1 = 206 * MB + 131072;
constexpr size_t OFF_AL = 206 * MB + 131072 + 4096;
constexpr size_t OFF_WGLUT = 207 * MB;
constexpr size_t OFF_WAT = 208 * MB;
constexpr size_t OFF_WBT = 209 * MB;
constexpr size_t OFF_WOUTT = 210 * MB;
constexpr size_t OFF_ROPE = 212 * MB;
constexpr size_t OFF_KT = 213 * MB;
constexpr size_t OFF_WIN5 = 214 * MB;
constexpr size_t OFF_WOUT5 = 222 * MB;
constexpr size_t OFF_H1 = 230 * MB;
constexpr size_t OFF_KCMP = 232 * MB;
constexpr size_t OFF_VCMPT = 232 * MB + 262144;
constexpr size_t OFF_E = 233 * MB;
constexpr size_t OFF_SPREV = 241 * MB;
constexpr size_t OFF_BAR = 244 * MB;
constexpr size_t OFF_RSS = 243 * MB;
constexpr size_t OFF_HP = 188 * MB;
constexpr size_t OFF_BP = 206 * MB + 262144;
constexpr size_t OFF_E2 = 233 * MB;
constexpr size_t OO_Q = 0, OO_QR = 16 * MB, OO_KC = 32 * MB, OO_VC = 36 * MB, OO_KS = 40 * MB, OO_KW = 44 * MB, OO_VST = 48 * MB, OO_VWT = 52 * MB;

struct Params {
  const float *x, *norm_g, *w_in, *pos_k, *pos_v, *w1k, *w2k, *w1v, *w2v, *lam_re, *lam_im, *log_dt, *b_re, *b_im, *c_re, *c_im,
      *s5d, *w_glu, *b_glu, *w_pa, *w_pb, *w_out, *final_g;
  float* out;
  char* ws;
};

__device__ __forceinline__ bf16_t f2bf(float f) {
  uint32_t u = __float_as_uint(f);
  u += 0x7fffu + ((u >> 16) & 1u);
  return (bf16_t)(u >> 16);
}
__device__ __forceinline__ float bf2f(bf16_t h) { return __uint_as_float(((uint32_t)h) << 16); }
__device__ __forceinline__ uint32_t pack2(float a, float b) { return (uint32_t)f2bf(a) | ((uint32_t)f2bf(b) << 16); }
__device__ __forceinline__ float rcpf_(float v) { return __builtin_amdgcn_rcpf(v); }
__device__ __forceinline__ float sigmoidf_(float v) { return rcpf_(1.0f + __builtin_amdgcn_exp2f(-1.4426950408889634f * v)); }
__device__ __forceinline__ float siluf_(float v) { return v * sigmoidf_(v); }
__device__ __forceinline__ float geluf_(float v) {
  float u = 0.7978845608028654f * (v + 0.044715f * v * v * v);
  return v * rcpf_(1.0f + __builtin_amdgcn_exp2f(-2.8853900817779268f * u));
}
typedef float f32x2_ __attribute__((ext_vector_type(2)));
typedef __bf16 bf16x2_ __attribute__((ext_vector_type(2)));
__device__ __forceinline__ uint32_t cvt_pk_bf16(float lo, float hi) { f32x2_ v; v.x = lo; v.y = hi; return __builtin_bit_cast(uint32_t, __builtin_convertvector(v, bf16x2_)); }
__device__ __forceinline__ uint4 pack8(const float (&v)[8]) { return make_uint4(cvt_pk_bf16(v[0], v[1]), cvt_pk_bf16(v[2], v[3]), cvt_pk_bf16(v[4], v[5]), cvt_pk_bf16(v[6], v[7])); }
__device__ __forceinline__ void unpack8(uint4 w, float (&v)[8]) {
  v[0] = __uint_as_float(w.x << 16); v[1] = __uint_as_float(w.x & 0xffff0000u); v[2] = __uint_as_float(w.y << 16); v[3] = __uint_as_float(w.y & 0xffff0000u);
  v[4] = __uint_as_float(w.z << 16); v[5] = __uint_as_float(w.z & 0xffff0000u); v[6] = __uint_as_float(w.w << 16); v[7] = __uint_as_float(w.w & 0xffff0000u);
}
__device__ __forceinline__ int otid() { int t = threadIdx.x; asm volatile("" : "+v"(t)); return t; }
__device__ __forceinline__ float ex2(float v) { return __builtin_amdgcn_exp2f(v); }

__device__ __forceinline__ void sincos_d(double a, double& s, double& c) {
  double n = rint(a * 0.6366197723675814);
  double r = fma(-n, 1.5707963267948966, a);
  r = fma(-n, 6.123233995736766e-17, r);
  int q = ((int)(long long)n) & 3;
  double r2 = r * r;
  double sp = r * (1.0 + r2 * (-1.0 / 6.0 + r2 * (1.0 / 120.0 + r2 * (-1.0 / 5040.0 + r2 * (1.0 / 362880.0 + r2 * (-1.0 / 39916800.0 + r2 * (1.0 / 6227020800.0)))))));
  double cp = 1.0 + r2 * (-0.5 + r2 * (1.0 / 24.0 + r2 * (-1.0 / 720.0 + r2 * (1.0 / 40320.0 + r2 * (-1.0 / 3628800.0 + r2 * (1.0 / 479001600.0 + r2 * (-1.0 / 87178291200.0)))))));
  if (q == 0) { s = sp; c = cp; }
  else if (q == 1) { s = cp; c = -sp; }
  else if (q == 2) { s = -sp; c = -cp; }
  else { s = -cp; c = sp; }
}

constexpr int LDS_STRIDE = 72;
constexpr int TILE_ELEMS = 128 * LDS_STRIDE;
constexpr int GEMM_SMEM_BYTES = 4 * TILE_ELEMS * 2;

__device__ __forceinline__ void gemm_compute(AccT& acc, const bf16_t* smem, int buf, int wr, int wc, int lane) {
  const bf16_t* sa = smem + buf * TILE_ELEMS + (wr * 64 + (lane & 15)) * LDS_STRIDE + (lane >> 4) * 8;
  const bf16_t* sb = smem + (2 + buf) * TILE_ELEMS + (wc * 64 + (lane & 15)) * LDS_STRIDE + (lane >> 4) * 8;
#pragma unroll
  for (int ks = 0; ks < 2; ++ks) {
    bf16x8 fa[4], fb[4];
#pragma unroll
    for (int m = 0; m < 4; ++m) { fa[m] = *(const bf16x8*)(sa + m * 16 * LDS_STRIDE + ks * 32); fb[m] = *(const bf16x8*)(sb + m * 16 * LDS_STRIDE + ks * 32); }
#pragma unroll
    for (int m = 0; m < 4; ++m)
#pragma unroll
      for (int n = 0; n < 4; ++n) acc[m][n] = __builtin_amdgcn_mfma_f32_16x16x32_bf16(fb[n], fa[m], acc[m][n], 0, 0, 0);
  }
}
template <class AL, class BL>
__device__ __forceinline__ void gemm_mainloop(AccT& acc, const AL& al, const BL& bl, int nk, bf16_t* smem) {
  const int tid = otid(), lane = tid & 63, wid = tid >> 6, wr = wid >> 1, wc = wid & 1;
  uint4 ra[4], rb[4];
#pragma unroll
  for (int i = 0; i < 4; ++i) { int id = tid + i * 256; ra[i] = al(id >> 3, 0, id & 7); rb[i] = bl(id >> 3, 0, id & 7); }
#pragma unroll
  for (int i = 0; i < 4; ++i) {
    int id = tid + i * 256; int row = id >> 3, q = id & 7;
    *(uint4*)(smem + row * LDS_STRIDE + q * 8) = ra[i];
    *(uint4*)(smem + 2 * TILE_ELEMS + row * LDS_STRIDE + q * 8) = rb[i];
  }
  __syncthreads();
#pragma unroll 1
  for (int it = 0; it < nk; ++it) {
    const int buf = it & 1;
    if (it + 1 < nk) {
#pragma unroll
      for (int i = 0; i < 4; ++i) { int id = tid + i * 256; ra[i] = al(id >> 3, it + 1, id & 7); rb[i] = bl(id >> 3, it + 1, id & 7); }
    }
    gemm_compute(acc, smem, buf, wr, wc, lane);
    if (it + 1 < nk) {
      const int nb = buf ^ 1;
#pragma unroll
      for (int i = 0; i < 4; ++i) {
        int id = tid + i * 256; int row = id >> 3, q = id & 7;
        *(uint4*)(smem + nb * TILE_ELEMS + row * LDS_STRIDE + q * 8) = ra[i];
        *(uint4*)(smem + (2 + nb) * TILE_ELEMS + row * LDS_STRIDE + q * 8) = rb[i];
      }
    }
    __syncthreads();
  }
}

constexpr int DMA_TILE = 128 * 64;
constexpr int RING_STAGE_BYTES = 16384;
template <bool DUAL>
__device__ __forceinline__ void gemm_ring_core(AccT& acc, AccT& acc2, const bf16_t* A, size_t lda, const bf16_t* B, size_t ldb,
                                               const bf16_t* A2, size_t lda2, const bf16_t* B2, size_t ldb2, int n1, int nk32, bf16_t* smem) {
  const int tid = otid(), lane = tid & 63, wid = tid >> 6, wr = wid >> 1, wc = wid & 1;
  const int prow = tid >> 2;
  const int pq = (tid & 3) ^ ((4 - ((prow >> 2) & 3)) & 3);
  const bf16_t* ga = A + (size_t)prow * lda + pq * 8;
  const bf16_t* gb = B + (size_t)prow * ldb + pq * 8;
  const bf16_t* ga2 = DUAL ? A2 + (size_t)prow * lda2 + pq * 8 : ga;
  const bf16_t* gb2 = DUAL ? B2 + (size_t)prow * ldb2 + pq * 8 : gb;
  char* lbase = (char*)smem + tid * 16;
#define RING_ISSUE(J) { const int stg_ = (J) & 3; const bool two_ = DUAL && (J) >= n1; \
    const bf16_t* pa_ = two_ ? ga2 + ((J) - n1) * 32 : ga + (J) * 32; const bf16_t* pb_ = two_ ? gb2 + ((J) - n1) * 32 : gb + (J) * 32; \
    const size_t la_ = two_ ? lda2 : lda, lb_ = two_ ? ldb2 : ldb; \
    _Pragma("unroll") for (int i_ = 0; i_ < 2; ++i_) { \
    __builtin_amdgcn_global_load_lds((const unsigned*)(pa_ + (size_t)(64 * i_) * la_), (unsigned*)(lbase + stg_ * RING_STAGE_BYTES + i_ * 4096), 16, 0, 0); \
    __builtin_amdgcn_global_load_lds((const unsigned*)(pb_ + (size_t)(64 * i_) * lb_), (unsigned*)(lbase + stg_ * RING_STAGE_BYTES + 8192 + i_ * 4096), 16, 0, 0); } }
  const int l15 = lane & 15, hq = lane >> 4;
  const int sw = (4 - (l15 >> 2)) & 3;
  const unsigned lds0 = (unsigned)(uintptr_t)(const __attribute__((address_space(3))) char*)smem;
  const unsigned offA = lds0 + (unsigned)((wr * 64 + l15) * 64 + ((hq ^ sw) << 4));
  const unsigned offB = lds0 + 8192u + (unsigned)((wc * 64 + l15) * 64 + ((hq ^ sw) << 4));
  asm volatile("s_waitcnt vmcnt(0)" ::: "memory");
  RING_ISSUE(0);
  if (nk32 > 1) RING_ISSUE(1);
  if (nk32 > 2) RING_ISSUE(2);
#pragma unroll 1
  for (int j = 0; j < nk32; ++j) {
    if (j + 2 < nk32) asm volatile("s_waitcnt vmcnt(8)" ::: "memory");
    else if (j + 1 < nk32) asm volatile("s_waitcnt vmcnt(4)" ::: "memory");
    else asm volatile("s_waitcnt vmcnt(0)" ::: "memory");
    asm volatile("s_waitcnt lgkmcnt(0)" ::: "memory");
    __builtin_amdgcn_s_barrier();
    const unsigned sa = offA + (unsigned)((j & 3) * RING_STAGE_BYTES), sb = offB + (unsigned)((j & 3) * RING_STAGE_BYTES);
    bf16x8 fa0, fa1, fa2, fa3, fb0, fb1, fb2, fb3;
    asm volatile(
        "ds_read_b128 %0, %8\n\t"
        "ds_read_b128 %1, %8 offset:1024\n\t"
        "ds_read_b128 %2, %8 offset:2048\n\t"
        "ds_read_b128 %3, %8 offset:3072\n\t"
        "ds_read_b128 %4, %9\n\t"
        "ds_read_b128 %5, %9 offset:1024\n\t"
        "ds_read_b128 %6, %9 offset:2048\n\t"
        "ds_read_b128 %7, %9 offset:3072"
        : "=&v"(fa0), "=&v"(fa1), "=&v"(fa2), "=&v"(fa3), "=&v"(fb0), "=&v"(fb1), "=&v"(fb2), "=&v"(fb3)
        : "v"(sa), "v"(sb)
        : "memory");
    if (j + 3 < nk32) RING_ISSUE(j + 3);
    asm volatile("s_waitcnt lgkmcnt(0)" : "+v"(fa0), "+v"(fa1), "+v"(fa2), "+v"(fa3), "+v"(fb0), "+v"(fb1), "+v"(fb2), "+v"(fb3) :: "memory");
    if (!DUAL || j < n1) {
    acc[0][0] = __builtin_amdgcn_mfma_f32_16x16x32_bf16(fb0, fa0, acc[0][0], 0, 0, 0);
    acc[0][1] = __builtin_amdgcn_mfma_f32_16x16x32_bf16(fb1, fa0, acc[0][1], 0, 0, 0);
    acc[0][2] = __builtin_amdgcn_mfma_f32_16x16x32_bf16(fb2, fa0, acc[0][2], 0, 0, 0);
    acc[0][3] = __builtin_amdgcn_mfma_f32_16x16x32_bf16(fb3, fa0, acc[0][3], 0, 0, 0);
    acc[1][0] = __builtin_amdgcn_mfma_f32_16x16x32_bf16(fb0, fa1, acc[1][0], 0, 0, 0);
    acc[1][1] = __builtin_amdgcn_mfma_f32_16x16x32_bf16(fb1, fa1, acc[1][1], 0, 0, 0);
    acc[1][2] = __builtin_amdgcn_mfma_f32_16x16x32_bf16(fb2, fa1, acc[1][2], 0, 0, 0);
    acc[1][3] = __builtin_amdgcn_mfma_f32_16x16x32_bf16(fb3, fa1, acc[1][3], 0, 0, 0);
    acc[2][0] = __builtin_amdgcn_mfma_f32_16x16x32_bf16(fb0, fa2, acc[2][0], 0, 0, 0);
    acc[2][1] = __builtin_amdgcn_mfma_f32_16x16x32_bf16(fb1, fa2, acc[2][1], 0, 0, 0);
    acc[2][2] = __builtin_amdgcn_mfma_f32_16x16x32_bf16(fb2, fa2, acc[2][2], 0, 0, 0);
    acc[2][3] = __builtin_amdgcn_mfma_f32_16x16x32_bf16(fb3, fa2, acc[2][3], 0, 0, 0);
    acc[3][0] = __builtin_amdgcn_mfma_f32_16x16x32_bf16(fb0, fa3, acc[3][0], 0, 0, 0);
    acc[3][1] = __builtin_amdgcn_mfma_f32_16x16x32_bf16(fb1, fa3, acc[3][1], 0, 0, 0);
    acc[3][2] = __builtin_amdgcn_mfma_f32_16x16x32_bf16(fb2, fa3, acc[3][2], 0, 0, 0);
    acc[3][3] = __builtin_amdgcn_mfma_f32_16x16x32_bf16(fb3, fa3, acc[3][3], 0, 0, 0);
    } else {
    acc2[0][0] = __builtin_amdgcn_mfma_f32_16x16x32_bf16(fb0, fa0, acc2[0][0], 0, 0, 0);
    acc2[0][1] = __builtin_amdgcn_mfma_f32_16x16x32_bf16(fb1, fa0, acc2[0][1], 0, 0, 0);
    acc2[0][2] = __builtin_amdgcn_mfma_f32_16x16x32_bf16(fb2, fa0, acc2[0][2], 0, 0, 0);
    acc2[0][3] = __builtin_amdgcn_mfma_f32_16x16x32_bf16(fb3, fa0, acc2[0][3], 0, 0, 0);
    acc2[1][0] = __builtin_amdgcn_mfma_f32_16x16x32_bf16(fb0, fa1, acc2[1][0], 0, 0, 0);
    acc2[1][1] = __builtin_amdgcn_mfma_f32_16x16x32_bf16(fb1, fa1, acc2[1][1], 0, 0, 0);
    acc2[1][2] = __builtin_amdgcn_mfma_f32_16x16x32_bf16(fb2, fa1, acc2[1][2], 0, 0, 0);
    acc2[1][3] = __builtin_amdgcn_mfma_f32_16x16x32_bf16(fb3, fa1, acc2[1][3], 0, 0, 0);
    acc2[2][0] = __builtin_amdgcn_mfma_f32_16x16x32_bf16(fb0, fa2, acc2[2][0], 0, 0, 0);
    acc2[2][1] = __builtin_amdgcn_mfma_f32_16x16x32_bf16(fb1, fa2, acc2[2][1], 0, 0, 0);
    acc2[2][2] = __builtin_amdgcn_mfma_f32_16x16x32_bf16(fb2, fa2, acc2[2][2], 0, 0, 0);
    acc2[2][3] = __builtin_amdgcn_mfma_f32_16x16x32_bf16(fb3, fa2, acc2[2][3], 0, 0, 0);
    acc2[3][0] = __builtin_amdgcn_mfma_f32_16x16x32_bf16(fb0, fa3, acc2[3][0], 0, 0, 0);
    acc2[3][1] = __builtin_amdgcn_mfma_f32_16x16x32_bf16(fb1, fa3, acc2[3][1], 0, 0, 0);
    acc2[3][2] = __builtin_amdgcn_mfma_f32_16x16x32_bf16(fb2, fa3, acc2[3][2], 0, 0, 0);
    acc2[3][3] = __builtin_amdgcn_mfma_f32_16x16x32_bf16(fb3, fa3, acc2[3][3], 0, 0, 0);
    }
  }
  asm volatile("s_waitcnt vmcnt(0) lgkmcnt(0)" ::: "memory");
  __syncthreads();
#undef RING_ISSUE
}

__device__ __forceinline__ void gemm_mainloop_dma(AccT& acc, const bf16_t* A, size_t lda, const bf16_t* B, size_t ldb, int nk, bf16_t* smem) {
  gemm_ring_core<false>(acc, acc, A, lda, B, ldb, A, lda, B, ldb, nk * 2, nk * 2, smem);
}
__device__ __forceinline__ void gemm_mainloop_dma2(AccT& acc, AccT& acc2, const bf16_t* A, size_t lda, const bf16_t* B, size_t ldb,
                                                   const bf16_t* A2, size_t lda2, const bf16_t* B2, size_t ldb2, int nk_each, bf16_t* smem) {
  gemm_ring_core<true>(acc, acc2, A, lda, B, ldb, A2, lda2, B2, ldb2, nk_each * 2, nk_each * 4, smem);
}

__device__ __forceinline__ void zero_acc(AccT& acc) {
#pragma unroll
  for (int m = 0; m < 4; ++m)
#pragma unroll
    for (int n = 0; n < 4; ++n) acc[m][n] = (f32x4){0.f, 0.f, 0.f, 0.f};
}

struct LdPlain {
  const bf16_t* base; size_t ld;
  __device__ __forceinline__ uint4 operator()(int row, int it, int q) const { return *(const uint4*)(base + (size_t)row * ld + it * 64 + q * 8); }
};

#define ACC_ROW(mi, reg, h) ((mi) * 32 + ((reg) & 3) + 8 * ((reg) >> 2) + 4 * (h))

constexpr int EP_STRIDE = 132;
template <bool TR>
__device__ __forceinline__ void acc_to_lds(const AccT& acc, float* Tl, int wr, int wc, int lane) {
  const int c4 = (lane >> 4) * 4, tl = lane & 15;
#pragma unroll
  for (int m = 0; m < 4; ++m)
#pragma unroll
    for (int n = 0; n < 4; ++n) {
      const int row = wr * 64 + m * 16 + tl, col = wc * 64 + n * 16 + c4;
      if (TR) {
#pragma unroll
        for (int reg = 0; reg < 4; ++reg) Tl[(col + reg) * EP_STRIDE + row] = acc[m][n][reg];
      } else {
        *(f32x4*)(Tl + row * EP_STRIDE + col) = acc[m][n];
      }
    }
}
__device__ __forceinline__ void lds_chunk8(const float* Tl, int row, int c8, float (&v)[8]) {
  const float4 a = *(const float4*)(Tl + row * EP_STRIDE + c8 * 8), b = *(const float4*)(Tl + row * EP_STRIDE + c8 * 8 + 4);
  v[0] = a.x; v[1] = a.y; v[2] = a.z; v[3] = a.w; v[4] = b.x; v[5] = b.y; v[6] = b.z; v[7] = b.w;
}
__device__ __forceinline__ void st8f(float* dst, const float (&v)[8]) {
  *(float4*)dst = make_float4(v[0], v[1], v[2], v[3]); *(float4*)(dst + 4) = make_float4(v[4], v[5], v[6], v[7]);
}
__device__ __forceinline__ void ld8f(const float* src, float (&v)[8]) {
  const float4 a = *(const float4*)src, b = *(const float4*)(src + 4);
  v[0] = a.x; v[1] = a.y; v[2] = a.z; v[3] = a.w; v[4] = b.x; v[5] = b.y; v[6] = b.z; v[7] = b.w;
}

__device__ __forceinline__ void transpose_tile(const float* __restrict__ src, int K, int N, bf16_t* __restrict__ dst, int kt, int nt, bool perm, float* sm) {
  const int tid = otid();
  const int k0 = kt * 64, n0 = nt * 64;
  float tv[16];
#pragma unroll
  for (int i = 0; i < 16; ++i) {
    int k = i * 4 + (tid >> 6), n = tid & 63;
    tv[i] = (n0 + n < N) ? src[(size_t)(k0 + k) * N + n0 + n] : 0.f;
  }
#pragma unroll
  for (int i = 0; i < 16; ++i) {
    int k = i * 4 + (tid >> 6), n = tid & 63;
    sm[k * 65 + n] = tv[i];
  }
  __syncthreads();
  {
    int n = tid >> 2, kq = (tid & 3) * 16;
    int ng = n0 + n;
    if (ng < N) {
      int dn = ng;
      if (perm) dn = ng < 1280 ? ng : (ng < 1304 ? 4864 + (ng - 1280) : ng - 24);
      uint32_t w[8];
#pragma unroll
      for (int i = 0; i < 8; ++i) w[i] = pack2(sm[(kq + 2 * i) * 65 + n], sm[(kq + 2 * i + 1) * 65 + n]);
      uint4* d = (uint4*)(dst + (size_t)dn * K + k0 + kq);
      d[0] = make_uint4(w[0], w[1], w[2], w[3]);
      d[1] = make_uint4(w[4], w[5], w[6], w[7]);
    }
  }
  __syncthreads();
}

__device__ __forceinline__ void s5_table_unit(const Params& p, int g, int tg, char* smem) {
  float2* ap = (float2*)smem;
  float2* zz = ap + 5 * 64;
  float2* bb = zz + 64;
  float* cR = (float*)(bb + 1024);
  float* cI = cR + 16 * 65;
  const int tid = otid();
#pragma unroll
  for (int i = 0; i < 4; ++i) {
    int idx = tid + i * 256;
    cR[(idx >> 6) * 65 + (idx & 63)] = p.c_re[(size_t)g * 1024 + idx];
    cI[(idx >> 6) * 65 + (idx & 63)] = p.c_im[(size_t)g * 1024 + idx];
  }
  const double dt = exp((double)p.log_dt[g]);
  if (tid < 64) {
    int pidx = g * 64 + tid;
    double lr = (double)p.lam_re[pidx], li = (double)p.lam_im[pidx];
    double mag = exp(lr * dt), s1, c1;
    sincos_d(li * dt, s1, c1);
    double ar = mag * c1, ai = mag * s1;
    double den = lr * lr + li * li;
    double zr = ((ar - 1.0) * lr + ai * li) / den;
    double zi = (ai * lr - (ar - 1.0) * li) / den;
    zz[tid] = make_float2((float)zr, (float)zi);
  }
  for (int e = tid; e < 320; e += 256) {
    const int tj = e >> 6, pp = e & 63, tau = tg * 5 + tj;
    if (tau <= 64) {
      const int pidx = g * 64 + pp;
      const double lr = (double)p.lam_re[pidx], li = (double)p.lam_im[pidx];
      double mt = exp(lr * dt * (double)tau), st, ct;
      sincos_d(li * dt * (double)tau, st, ct);
      const float2 a = make_float2((float)(mt * ct), (float)(mt * st));
      ap[tj * 64 + pp] = a;
      if (tau == 64) ((float2*)(p.ws + OFF_AL))[pidx] = a;
    }
  }
  __syncthreads();
#pragma unroll
  for (int i = 0; i < 4; ++i) {
    int idx = tid + i * 256; int pp = idx >> 4, ci = idx & 15;
    float br = p.b_re[(size_t)(g * 64 + pp) * 16 + ci], bi = p.b_im[(size_t)(g * 64 + pp) * 16 + ci];
    float2 z = zz[pp];
    bb[idx] = make_float2(z.x * br - z.y * bi, z.x * bi + z.y * br);
  }
  __syncthreads();
#pragma unroll 1
  for (int tj = 0; tj < 5; ++tj) {
    const int tau = tg * 5 + tj;
    if (tau > 64) break;
    const float2* apt = ap + tj * 64;
    if (tau < 64) {
      {
        int co = tid >> 4, ci = tid & 15;
        float acc = 0.f;
#pragma unroll 8
        for (int pp = 0; pp < 64; ++pp) {
          float cr = cR[co * 65 + pp], cim = cI[co * 65 + pp];
          float2 a = apt[pp], b2 = bb[pp * 16 + ci];
          float wr_ = a.x * b2.x - a.y * b2.y, wi_ = a.x * b2.y + a.y * b2.x;
          acc += cr * wr_ - cim * wi_;
        }
        ((bf16_t*)(p.ws + OFF_KT))[((size_t)(g * 64 + tau) * 16 + co) * 16 + ci] = f2bf(acc);
      }
      {
        int j = 63 - tau;
        bf16_t* W = (bf16_t*)(p.ws + OFF_WIN5) + (size_t)g * 128 * 1024;
#pragma unroll
        for (int i = 0; i < 8; ++i) {
          int idx = tid + i * 256; int n = idx >> 4, ci = idx & 15; int pp = n & 63;
          float2 a = apt[pp], b2 = bb[pp * 16 + ci];
          float v = (n < 64) ? (a.x * b2.x - a.y * b2.y) : (a.x * b2.y + a.y * b2.x);
          W[(size_t)n * 1024 + j * 16 + ci] = f2bf(v);
        }
      }
    }
    if (tau >= 1) {
      int i_ = tau - 1;
      bf16_t* W = (bf16_t*)(p.ws + OFF_WOUT5) + (size_t)g * 1024 * 128;
#pragma unroll
      for (int i = 0; i < 8; ++i) {
        int idx = tid + i * 256; int co = idx >> 7, k = idx & 127; int pp = k & 63;
        float cr = cR[co * 65 + pp], cim = cI[co * 65 + pp];
        float2 a = apt[pp];
        float er = cr * a.x - cim * a.y, ei = cr * a.y + cim * a.x;
        W[(size_t)(i_ * 16 + co) * 128 + k] = f2bf(k < 64 ? er : -ei);
      }
    }
  }
  __syncthreads();
}

__shared__ int q0_s;
__device__ __forceinline__ void phase0(const Params& p, char* smem) {
  const int tid = otid(), lane = tid & 63, wid = tid >> 6;
  constexpr int U_HN = 1024;
  constexpr int U_WIN = 16 * 77;
  constexpr int U_W1 = 32 * 4;
  constexpr int U_W2 = 4;
  constexpr int U_GLU = 64, U_PA = 8 * 16, U_PB = 8 * 16, U_OUT = 256;
  constexpr int U_BIAS = 128, U_ROPE = 512, U_S5 = 32 * 13;
  constexpr int B0 = 0, B1 = B0 + U_S5, B2 = B1 + U_BIAS, B3 = B2 + U_WIN, B4 = B3 + 2 * U_W1, B5 = B4 + 2 * U_W2, B6 = B5 + U_GLU,
                B7 = B6 + U_PA, B8 = B7 + U_PB, B9 = B8 + U_OUT, B10 = B9 + U_ROPE, B11 = B10 + U_HN;
  constexpr int NTK = B11 - (B9 - B5);
#if MULTI_LAUNCH
  for (int qk = blockIdx.x; qk < NTK; qk += gridDim.x) {
#else
  unsigned* qctr = (unsigned*)(p.ws + OFF_BAR) + 3456 + 1024;
  for (;;) {
    __syncthreads();
    if (tid == 0) q0_s = (int)__hip_atomic_fetch_add(qctr, 1u, __ATOMIC_RELAXED, __HIP_MEMORY_SCOPE_AGENT);
    __syncthreads();
    const int qk = q0_s;
    if (qk >= NTK) break;
#endif
    int u0;
    if (qk < U_S5) u0 = qk;
    else if (qk < U_S5 + U_HN) u0 = (B5 + U_ROPE) + (qk - U_S5);
    else u0 = B1 + (qk - U_S5 - U_HN);
    const int u = u0 < B5 ? u0 : u0 + (B9 - B5);
    if (u < B1) {
      s5_table_unit(p, u / 13, u % 13, smem);
    } else if (u < B2) {
      int v = u - B1; int kv = v >> 6, sl = v & 63;
      const float* w1 = kv ? p.w1v : p.w1k; const float* pos = kv ? p.pos_v : p.pos_k;
      float acc = 0.f;
#pragma unroll
      for (int k = 0; k < 32; ++k) acc += pos[sl * 32 + k] * w1[(size_t)(sl * 32 + k) * 256 + tid];
      ((float*)(p.ws + OFF_BP))[(kv * 64 + sl) * 256 + tid] = acc;
    } else if (u < B3) {
      int v = u - B2; transpose_tile(p.w_in, 1024, 4888, (bf16_t*)(p.ws + OFF_WINT), v / 77, v % 77, true, (float*)smem);
    } else if (u < B4) {
      int v = u - B3; int kv = v / U_W1; v %= U_W1;
      transpose_tile(kv ? p.w1v : p.w1k, 2048, 256, (bf16_t*)(p.ws + (kv ? OFF_W1VT : OFF_W1KT)), v >> 2, v & 3, false, (float*)smem);
    } else if (u < B5) {
      int v = u - B4; int kv = v / U_W2; v %= U_W2;
      transpose_tile(kv ? p.w2v : p.w2k, 256, 64, (bf16_t*)(p.ws + (kv ? OFF_W2VT : OFF_W2KT)), v, 0, false, (float*)smem);
    } else if (u < B10) {
      int idx = (u - B9) * 256 + tid;
      int pos = idx >> 5, j = idx & 31;
      float invf = (float)exp(-(double)j * (9.210340371976184 / 32.0));
      float ang = (float)pos * invf;
      double s, c; sincos_d((double)ang, s, c);
      ((float2*)(p.ws + OFF_ROPE))[idx] = make_float2((float)c, (float)s);
    } else {
      const int row0 = (u - B10) * 16 + wid * 4;
      float4 v[4][4]; float ss[4];
#pragma unroll
      for (int r = 0; r < 4; ++r) {
        const float4* xr = (const float4*)(p.x + (size_t)(row0 + r) * DM);
#pragma unroll
        for (int i = 0; i < 4; ++i) v[r][i] = xr[lane + i * 64];
      }
      float4 g[4];
#pragma unroll
      for (int i = 0; i < 4; ++i) g[i] = ((const float4*)p.norm_g)[lane + i * 64];
#pragma unroll
      for (int r = 0; r < 4; ++r) {
        ss[r] = 0.f;
#pragma unroll
        for (int i = 0; i < 4; ++i) ss[r] += v[r][i].x * v[r][i].x + v[r][i].y * v[r][i].y + v[r][i].z * v[r][i].z + v[r][i].w * v[r][i].w;
      }
#pragma unroll
      for (int o = 32; o >= 1; o >>= 1) {
#pragma unroll
        for (int r = 0; r < 4; ++r) ss[r] += __shfl_xor(ss[r], o);
      }
#pragma unroll
      for (int r = 0; r < 4; ++r) {
        const float rs = rsqrtf(ss[r] * (1.0f / DM) + 1.0e-6f);
        bf16_t* hn = (bf16_t*)(p.ws + OFF_HN) + (size_t)(row0 + r) * DM;
#pragma unroll
        for (int i = 0; i < 4; ++i) {
          uint2 w; w.x = cvt_pk_bf16(v[r][i].x * rs * g[i].x, v[r][i].y * rs * g[i].y); w.y = cvt_pk_bf16(v[r][i].z * rs * g[i].z, v[r][i].w * rs * g[i].w);
          *(uint2*)(hn + (lane + i * 64) * 4) = w;
        }
      }
    }
  }
}

__shared__ int xinfo_s[4];
__device__ __forceinline__ bool xcd_tile(int i, int nct, int& rt, int& ct) {
#if MULTI_LAUNCH
  const int G = gridDim.x;
  int t = blockIdx.x + i * G; if (t >= 128 * nct) return false; rt = t / nct; ct = t % nct; return true;
#else
  const int xi = xinfo_s[0], nx = xinfo_s[1], rank = xinfo_s[2], nloc = xinfo_s[3];
  const int r_lo = (xi * 128) / nx, r_hi = ((xi + 1) * 128) / nx, nrt = r_hi - r_lo;
  const int L = i * nloc + rank; if (L >= nrt * nct) return false;
  ct = L / nrt; rt = r_lo + (L - ct * nrt); return true;
#endif
}

constexpr float QSCALE = 0.125f * 1.4426950408889634f;

__device__ __forceinline__ void proj_epilogue(const Params& p, AccT& acc, int m0, int ct, float* Tl, int wr, int wc, int lane, int tid) {
  const int b = m0 >> 12, tb = m0 & 4095;
  char* oo = (char*)p.out;
  if (ct == 7 || ct == 9) acc_to_lds<true>(acc, Tl, wr, wc, lane); else acc_to_lds<false>(acc, Tl, wr, wc, lane);
  __syncthreads();
  if (ct < 4 || ct == 6 || ct == 8) {
    const float2* rope = (const float2*)(p.ws + OFF_ROPE);
#pragma unroll 2
    for (int i = 0; i < 4; ++i) {
      const int id = tid + i * 256; const int j = id & 3, hh = (id >> 2) & 1, row = id >> 3;
      const int tl = tb + row;
      const float4* rp = (const float4*)(rope + tl * 32 + j * 8);
      const float4 r0 = rp[0], r1 = rp[1], r2 = rp[2], r3 = rp[3];
      float a[8], bq[8];
      lds_chunk8(Tl, row, hh * 8 + j, a); lds_chunk8(Tl, row, hh * 8 + 4 + j, bq);
      const float cs[8] = {r0.x, r0.z, r1.x, r1.z, r2.x, r2.z, r3.x, r3.z};
      const float sn[8] = {r0.y, r0.w, r1.y, r1.w, r2.y, r2.w, r3.y, r3.w};
      float ra[8], rb[8];
#pragma unroll
      for (int k = 0; k < 8; ++k) { ra[k] = a[k] * cs[k] - bq[k] * sn[k]; rb[k] = bq[k] * cs[k] + a[k] * sn[k]; }
      if (ct < 4) {
        const int hd = ct * 2 + hh;
        const size_t o = ((size_t)(b * T_ + tl)) * 512 + hd * 64 + j * 8;
#pragma unroll
        for (int k = 0; k < 8; ++k) { a[k] *= QSCALE; bq[k] *= QSCALE; ra[k] *= QSCALE; rb[k] *= QSCALE; }
        bf16_t* Q = (bf16_t*)(oo + OO_Q); bf16_t* QR = (bf16_t*)(oo + OO_QR);
        *(uint4*)(Q + o) = pack8(a); *(uint4*)(Q + o + 32) = pack8(bq);
        *(uint4*)(QR + o) = pack8(ra); *(uint4*)(QR + o + 32) = pack8(rb);
      } else {
        bf16_t* Kd = (bf16_t*)(oo + (ct == 6 ? OO_KS : OO_KW));
        const size_t o = ((size_t)((b * 2 + hh) * T_ + tl)) * 64 + j * 8;
        *(uint4*)(Kd + o) = pack8(ra); *(uint4*)(Kd + o + 32) = pack8(rb);
      }
    }
  } else {
#pragma unroll 2
    for (int i = 0; i < 8; ++i) {
      const int id = tid + i * 256; const int row = id >> 4, c8 = id & 15;
      float v[8]; lds_chunk8(Tl, row, c8, v);
      const size_t tok = (size_t)b * T_ + tb + row;
      if (ct == 4 || ct == 5) {
        bf16_t* Kd = (bf16_t*)(oo + (ct == 4 ? OO_KC : OO_VC));
        *(uint4*)(Kd + ((size_t)((b * 2 + (c8 >> 3)) * T_ + tb + row)) * 64 + (c8 & 7) * 8) = pack8(v);
      } else if (ct == 7 || ct == 9) {
        bf16_t* Vd = (bf16_t*)(oo + (ct == 7 ? OO_VST : OO_VWT));
        *(uint4*)(Vd + ((size_t)((b * 2 + (row >> 6)) * 64 + (row & 63))) * T_ + tb + c8 * 8) = pack8(v);
      } else if (ct < 14) {
#pragma unroll
        for (int k = 0; k < 8; ++k) v[k] = siluf_(v[k]);
        *(uint4*)((bf16_t*)(p.ws + OFF_GN) + tok * 512 + (ct - 10) * 128 + c8 * 8) = pack8(v);
      } else if (ct < 18) {
        const int ch0 = (ct - 14) * 128 + c8 * 8;
        *(uint4*)((bf16_t*)(p.ws + OFF_U2) + ((size_t)(b * 32 + (ch0 >> 4)) * T_ + tb + row) * 16 + (ch0 & 15)) = pack8(v);
      } else if (ct < 22) {
#pragma unroll
        for (int k = 0; k < 8; ++k) v[k] = siluf_(v[k]);
        *(uint4*)((bf16_t*)(p.ws + OFF_GS) + tok * 512 + (ct - 18) * 128 + c8 * 8) = pack8(v);
      } else if (ct < 38) {
#pragma unroll
        for (int k = 0; k < 8; ++k) v[k] = sigmoidf_(v[k]);
        bf16_t* M = (bf16_t*)(p.ws + (ct < 30 ? OFF_MGA : OFF_MGB));
        *(uint4*)(M + tok * 1024 + ((ct - 22) & 7) * 128 + c8 * 8) = pack8(v);
      } else if (c8 < 3) {
#pragma unroll
        for (int k = 0; k < 8; ++k) v[k] = sigmoidf_(v[k]);
        st8f((float*)(p.ws + OFF_GL) + tok * 32 + c8 * 8, v);
      }
    }
  }
  __syncthreads();
}

__device__ __forceinline__ void phase1(const Params& p, char* smem) {
  const int tid_ = otid(); const int lane = tid_ & 63, wid = tid_ >> 6, wr = wid >> 1, wc = wid & 1;
  for (int i = 0;; ++i) {
    int rt, ct; if (!xcd_tile(i, 39, rt, ct)) break;
    AccT acc; zero_acc(acc);
    gemm_mainloop_dma(acc, (const bf16_t*)(p.ws + OFF_HN) + (size_t)rt * 128 * DM, DM, (const bf16_t*)(p.ws + OFF_WINT) + (size_t)ct * 128 * DM, DM, 16, (bf16_t*)smem);
    proj_epilogue(p, acc, rt * 128, ct, (float*)smem, wr, wc, lane, tid_);
  }
}

struct LdCmpA {
  const bf16_t* base; int m0, koff;
  __device__ __forceinline__ uint4 operator()(int row, int it, int q) const {
    int r = m0 + row; int bg = r >> 8, c = r & 255; if (c > 254) c = 254;
    return *(const uint4*)(base + ((size_t)bg * T_ + c * 16) * 64 + koff + it * 64 + q * 8);
  }
};
struct LdS5U {
  const bf16_t* u2; int g, m0, koff;
  __device__ __forceinline__ uint4 operator()(int row, int it, int q) const {
    int r = m0 + row; int b = r >> 6, c = r & 63;
    return *(const uint4*)(u2 + ((size_t)(b * 32 + g) * T_ + c * 64) * 16 + koff + it * 64 + q * 8);
  }
};

__device__ __forceinline__ void phase2(const Params& p, char* smem) {
  const int tid_ = otid(); const int lane = tid_ & 63, wid = tid_ >> 6, wr = wid >> 1, wc = wid & 1, h = lane >> 5, cl = lane & 31;
  for (int t = blockIdx.x; t < 256 + 128 + 2; t += gridDim.x) {
    if (t < 256) {
      AccT acc; zero_acc(acc);
      int kv = t >> 7, sp = (t >> 5) & 3, rt = (t >> 1) & 15, ct = t & 1;
      LdCmpA al{(const bf16_t*)((char*)p.out + (kv ? OO_VC : OO_KC)), rt * 128, sp * 512};
      LdPlain bl{(const bf16_t*)(p.ws + (kv ? OFF_W1VT : OFF_W1KT)) + (size_t)ct * 128 * 2048 + sp * 512, 2048};
      gemm_mainloop(acc, al, bl, 8, (bf16_t*)smem);
      float* HP = (float*)(p.ws + OFF_HP) + (size_t)(kv * 4 + sp) * 2048 * 256;
      float* Tl = (float*)smem;
      acc_to_lds<false>(acc, Tl, wr, wc, lane);
      __syncthreads();
#pragma unroll 2
      for (int i = 0; i < 8; ++i) {
        const int id = tid_ + i * 256; const int row = id >> 4, c8 = id & 15;
        float v[8]; lds_chunk8(Tl, row, c8, v);
        st8f(HP + (size_t)(rt * 128 + row) * 256 + ct * 128 + c8 * 8, v);
      }
      __syncthreads();
    } else if (t < 384) {
      AccT acc; zero_acc(acc);
      int v = t - 256; int g = v >> 2, rt = (v >> 1) & 1, sp = v & 1;
      LdS5U al{(const bf16_t*)(p.ws + OFF_U2), g, rt * 128, sp * 512};
      LdPlain bl{(const bf16_t*)(p.ws + OFF_WIN5) + (size_t)g * 128 * 1024 + sp * 512, 1024};
      gemm_mainloop(acc, al, bl, 8, (bf16_t*)smem);
      float* E = (float*)(p.ws + OFF_E2) + ((size_t)sp * 32 + g) * 256 * 128;
      float* Tl = (float*)smem;
      acc_to_lds<false>(acc, Tl, wr, wc, lane);
      __syncthreads();
#pragma unroll 2
      for (int i = 0; i < 8; ++i) {
        const int id = tid_ + i * 256; const int row = id >> 4, c8 = id & 15;
        float v[8]; lds_chunk8(Tl, row, c8, v);
        st8f(E + (size_t)(rt * 128 + row) * 128 + c8 * 8, v);
      }
      __syncthreads();
    } else {
      int kv = t - 384;
      const float* BP = (const float*)(p.ws + OFF_BP) + kv * 64 * 256;
      float a = 0.f;
#pragma unroll 16
      for (int i = 0; i < 64; ++i) a += BP[i * 256 + tid_];
      ((float*)(p.ws + OFF_BIAS1))[kv * 256 + tid_] = a;
    }
  }
}

struct LdHid {
  const float* hp; const float* bias; int m0;
  __device__ __forceinline__ uint4 operator()(int row, int it, int q) const {
    int n0 = it * 64 + q * 8;
    const float* b0 = hp + (size_t)(m0 + row) * 256 + n0;
    float4 x0 = *(const float4*)(bias + n0), x1 = *(const float4*)(bias + n0 + 4);
#pragma unroll
    for (int sp = 0; sp < 4; ++sp) {
      float4 a = *(const float4*)(b0 + (size_t)sp * 2048 * 256), b = *(const float4*)(b0 + (size_t)sp * 2048 * 256 + 4);
      x0.x += a.x; x0.y += a.y; x0.z += a.z; x0.w += a.w; x1.x += b.x; x1.y += b.y; x1.z += b.z; x1.w += b.w;
    }
    return make_uint4(pack2(geluf_(x0.x), geluf_(x0.y)), pack2(geluf_(x0.z), geluf_(x0.w)), pack2(geluf_(x1.x), geluf_(x1.y)), pack2(geluf_(x1.z), geluf_(x1.w)));
  }
};

__device__ __forceinline__ void phase3(const Params& p, char* smem) {
  const int tid = otid(), lane = tid & 63, wid = tid >> 6, wr = wid >> 1, wc = wid & 1, h = lane >> 5, cl = lane & 31;
#if MULTI_LAUNCH
  for (int t = blockIdx.x; t < 64 + 576; t += gridDim.x) {
#else
  unsigned* q3 = (unsigned*)(p.ws + OFF_BAR) + 3456 + 1024 + 16 + 16 * 18;
  for (;;) {
    __syncthreads();
    if (tid == 0) q0_s = (int)__hip_atomic_fetch_add(q3, 1u, __ATOMIC_RELAXED, __HIP_MEMORY_SCOPE_AGENT);
    __syncthreads();
    const int t = q0_s;
    if (t >= 64 + 576) break;
#endif
    if (t >= 64) {
      const int v0 = t - 64;
      if (v0 < 64) { transpose_tile(p.w_glu, 512, 512, (bf16_t*)(p.ws + OFF_WGLUT), v0 >> 3, v0 & 7, false, (float*)smem); }
      else if (v0 < 192) { const int v = v0 - 64; transpose_tile(p.w_pa, 512, 1024, (bf16_t*)(p.ws + OFF_WAT), v >> 4, v & 15, false, (float*)smem); }
      else if (v0 < 320) { const int v = v0 - 192; transpose_tile(p.w_pb, 512, 1024, (bf16_t*)(p.ws + OFF_WBT), v >> 4, v & 15, false, (float*)smem); }
      else { const int v = v0 - 320; transpose_tile(p.w_out, 1024, 1024, (bf16_t*)(p.ws + OFF_WOUTT), v >> 4, v & 15, false, (float*)smem); }
    } else if (t < 32) {
      int kv = t >> 4, rt = t & 15;
      AccT acc; zero_acc(acc);
      LdHid al{(const float*)(p.ws + OFF_HP) + (size_t)kv * 4 * 2048 * 256, (const float*)(p.ws + OFF_BIAS1) + kv * 256, rt * 128};
      LdPlain bl{(const bf16_t*)(p.ws + (kv ? OFF_W2VT : OFF_W2KT)), 256};
      gemm_mainloop(acc, al, bl, 4, (bf16_t*)smem);
      float* Tl = (float*)smem;
      if (kv == 0) {
        acc_to_lds<false>(acc, Tl, wr, wc, lane);
        __syncthreads();
        bf16_t* KC = (bf16_t*)(p.ws + OFF_KCMP);
#pragma unroll 2
        for (int i = 0; i < 4; ++i) {
          const int id = tid + i * 256; const int row = id >> 3, c8 = id & 7;
          float v[8]; lds_chunk8(Tl, row, c8, v);
          const int grow = rt * 128 + row;
          if ((grow & 255) == 255) {
#pragma unroll
            for (int k = 0; k < 8; ++k) v[k] = 0.f;
          }
          *(uint4*)(KC + (size_t)grow * 64 + c8 * 8) = pack8(v);
        }
      } else {
        acc_to_lds<true>(acc, Tl, wr, wc, lane);
        __syncthreads();
        bf16_t* VT = (bf16_t*)(p.ws + OFF_VCMPT);
#pragma unroll 2
        for (int i = 0; i < 4; ++i) {
          const int id = tid + i * 256; const int d = id >> 4, c8 = id & 15;
          float v[8]; lds_chunk8(Tl, d, c8, v);
          const int grow = rt * 128 + c8 * 8; const int bg = grow >> 8, c0 = grow & 255;
          if (c0 == 248) v[7] = 0.f;
          *(uint4*)(VT + ((size_t)bg * 64 + d) * 256 + c0) = pack8(v);
        }
      }
      __syncthreads();
    } else {
      int idx = (t - 32) * 256 + tid;
      int pp = idx & 63, g = (idx >> 6) & 31, b = idx >> 11;
      float2 a = ((const float2*)(p.ws + OFF_AL))[g * 64 + pp];
      const float* E0 = (const float*)(p.ws + OFF_E2) + ((size_t)g * 256 + b * 64) * 128;
      const float* E1 = E0 + (size_t)32 * 256 * 128;
      bf16_t* S = (bf16_t*)(p.ws + OFF_SPREV) + ((size_t)g * 256 + b * 64) * 128;
      float sr = 0.f, si = 0.f;
#pragma unroll 1
      for (int cb = 0; cb < 64; cb += 16) {
        float er[16], ei[16];
#pragma unroll
        for (int c = 0; c < 16; ++c) {
          er[c] = E0[(cb + c) * 128 + pp] + E1[(cb + c) * 128 + pp];
          ei[c] = E0[(cb + c) * 128 + 64 + pp] + E1[(cb + c) * 128 + 64 + pp];
        }
#pragma unroll
        for (int c = 0; c < 16; ++c) {
          S[(cb + c) * 128 + pp] = f2bf(sr); S[(cb + c) * 128 + 64 + pp] = f2bf(si);
          float nr = a.x * sr - a.y * si + er[c], ni_ = a.x * si + a.y * sr + ei[c];
          sr = nr; si = ni_;
        }
      }
    }
  }
}

constexpr int KS_STRIDE = 72, VS_STRIDE = 68;
constexpr int KS_ELEMS = 64 * KS_STRIDE, VS_ELEMS = 64 * VS_STRIDE;
constexpr int NSA_KV_BYTES = 2 * (KS_ELEMS + VS_ELEMS) * 2;
constexpr int NSA_SMEM_BYTES = NSA_KV_BYTES + 4 * 32 * 65 * 4 + 32 * 65 * 4 + 256;


#define TRD uint4 &tk0, uint4 &tk1, uint4 &tv0, uint4 &tv1
#define TRA tk0, tk1, tv0, tv1
__device__ __forceinline__ void tile_gload(TRD, const bf16_t* kbase, const bf16_t* vbase, size_t vstride, int n, int tid) {
  const int r = tid >> 3, q = tid & 7;
  tk0 = *(const uint4*)(kbase + (size_t)(n * 64 + r) * 64 + q * 8);
  tk1 = *(const uint4*)(kbase + (size_t)(n * 64 + r + 32) * 64 + q * 8);
  tv0 = *(const uint4*)(vbase + (size_t)r * vstride + n * 64 + q * 8);
  tv1 = *(const uint4*)(vbase + (size_t)(r + 32) * vstride + n * 64 + q * 8);
}
__device__ __forceinline__ void tile_sstore(TRD, bf16_t* Ks, bf16_t* Vs, int tid) {
  const int r = tid >> 3, q = tid & 7;
  *(uint4*)(Ks + r * KS_STRIDE + q * 8) = tk0;
  *(uint4*)(Ks + (r + 32) * KS_STRIDE + q * 8) = tk1;
  *(uint2*)(Vs + r * VS_STRIDE + q * 8) = make_uint2(tv0.x, tv0.y);
  *(uint2*)(Vs + r * VS_STRIDE + q * 8 + 4) = make_uint2(tv0.z, tv0.w);
  *(uint2*)(Vs + (r + 32) * VS_STRIDE + q * 8) = make_uint2(tv1.x, tv1.y);
  *(uint2*)(Vs + (r + 32) * VS_STRIDE + q * 8 + 4) = make_uint2(tv1.z, tv1.w);
}

__device__ __forceinline__ float xhalf_max(float v) {
  auto r = __builtin_amdgcn_permlane32_swap(__float_as_uint(v), __float_as_uint(v), false, false);
  return fmaxf(__uint_as_float(r[0]), __uint_as_float(r[1]));
}
__device__ __forceinline__ float xhalf_other(float v, int h) {
  auto r = __builtin_amdgcn_permlane32_swap(__float_as_uint(v), __float_as_uint(v), false, false);
  return __uint_as_float(h ? r[0] : r[1]);
}
__device__ __forceinline__ float xhalf_sum(float v) {
  auto r = __builtin_amdgcn_permlane32_swap(__float_as_uint(v), __float_as_uint(v), false, false);
  return __uint_as_float(r[0]) + __uint_as_float(r[1]);
}
__device__ __forceinline__ void qk_tile(const bf16_t* Ks, const bf16x8 (&Qf)[4], f32x16 (&S)[2], int cl, int h) {
#pragma unroll
  for (int kt = 0; kt < 2; ++kt) {
    if (kt) asm volatile("" ::: "memory");
#pragma unroll
    for (int r = 0; r < 16; ++r) S[kt][r] = 0.f;
#pragma unroll
    for (int kk = 0; kk < 4; ++kk) {
      bf16x8 kf = *(const bf16x8*)(Ks + (kt * 32 + cl) * KS_STRIDE + kk * 16 + h * 8);
      S[kt] = __builtin_amdgcn_mfma_f32_32x32x16_bf16(kf, Qf[kk], S[kt], 0, 0, 0);
    }
  }
}
__device__ __forceinline__ void pv_tile(const bf16_t* Vs, const f32x16 (&S)[2], f32x16 (&O)[2], int cl, int h) {
#pragma unroll
  for (int kt = 0; kt < 2; ++kt)
#pragma unroll
    for (int s2 = 0; s2 < 2; ++s2) {
      if (kt | s2) asm volatile("" ::: "memory");
      u32x4 pu;
      pu.x = cvt_pk_bf16(S[kt][8 * s2 + 0], S[kt][8 * s2 + 1]); pu.y = cvt_pk_bf16(S[kt][8 * s2 + 2], S[kt][8 * s2 + 3]);
      pu.z = cvt_pk_bf16(S[kt][8 * s2 + 4], S[kt][8 * s2 + 5]); pu.w = cvt_pk_bf16(S[kt][8 * s2 + 6], S[kt][8 * s2 + 7]);
      const bf16x8 pfv = __builtin_bit_cast(bf16x8, pu);
#pragma unroll
      for (int dt = 0; dt < 2; ++dt) {
        const bf16_t* vp = Vs + (dt * 32 + cl) * VS_STRIDE + kt * 32 + s2 * 16 + 4 * h;
        const uint2 va0 = *(const uint2*)(vp), va1 = *(const uint2*)(vp + 8);
        u32x4 vu; vu.x = va0.x; vu.y = va0.y; vu.z = va1.x; vu.w = va1.y;
        O[dt] = __builtin_amdgcn_mfma_f32_32x32x16_bf16(__builtin_bit_cast(bf16x8, vu), pfv, O[dt], 0, 0, 0);
      }
    }
}

template <class VF>
__device__ __forceinline__ void attn_tile64(const bf16_t* Ks, const bf16_t* Vs, const bf16x8 (&Qf)[4], f32x16 (&O)[2], float& m, float& l, bool bit, bool mask_on,
                                            const VF& valid, int cl, int h) {
  f32x16 S[2];
  qk_tile(Ks, Qf, S, cl, h);
  if (mask_on) {
#pragma unroll
    for (int kt = 0; kt < 2; ++kt)
#pragma unroll
      for (int r = 0; r < 16; ++r) S[kt][r] = valid(kt, r) ? S[kt][r] : -1.0e30f;
  }
  float mx = -1.0e30f;
#pragma unroll
  for (int kt = 0; kt < 2; ++kt)
#pragma unroll
    for (int r = 0; r < 16; ++r) mx = fmaxf(mx, S[kt][r]);
  mx = xhalf_max(mx);
  if (__ballot(bit && (mx > m + 8.0f)) != 0ull) {
    const float mnew = bit ? fmaxf(m, mx) : m;
    const float alpha = ex2(m - mnew);
    l *= alpha;
#pragma unroll
    for (int dt = 0; dt < 2; ++dt)
#pragma unroll
      for (int r = 0; r < 16; ++r) O[dt][r] *= alpha;
    m = mnew;
  }
  const float meff = bit ? m : 1.0e30f;
  float ps = 0.f;
#pragma unroll
  for (int kt = 0; kt < 2; ++kt)
#pragma unroll
    for (int r = 0; r < 16; ++r) {
      float pv = ex2(S[kt][r] - meff);
      S[kt][r] = pv; ps += pv;
    }
  l += ps;
  pv_tile(Vs, S, O, cl, h);
}

__device__ __forceinline__ void nsa_unit(const Params& p, int b, int g, int qt, char* smem) {
  const int tid = otid(), lane = tid & 63, w = tid >> 6, h = lane >> 5, cl = lane & 31;
  bf16_t* KsB = (bf16_t*)smem;
  bf16_t* VsB = KsB + 2 * KS_ELEMS;
  float* impS = (float*)(smem + NSA_KV_BYTES);
  float* valS = impS + 4 * 32 * 65;
  unsigned char* maskS = (unsigned char*)(valS + 32 * 65);
  const int hd = g * 4 + w, bg = b * 2 + g;
  const int t0 = qt * 32, tq = t0 + cl;
  const char* oo = (const char*)p.out;
  const size_t qoff = ((size_t)(b * T_ + tq)) * 512 + hd * 64 + h * 8;
  bf16x8 Qf[4];
#pragma unroll
  for (int kk = 0; kk < 4; ++kk) Qf[kk] = *(const bf16x8*)((const bf16_t*)(oo + OO_Q) + qoff + kk * 16);
  f32x16 Of[2];
#define GLV(k) (((const float*)(p.ws + OFF_GL))[((size_t)(b * T_ + tq)) * 32 + hd * 3 + (k)])
  uint4 tk0, tk1, tv0, tv1;
  {
    const int nct = ((2 * qt) >> 6) + 1;
    const bf16_t* KC = (const bf16_t*)(p.ws + OFF_KCMP) + (size_t)bg * 256 * 64;
    const bf16_t* VCT = (const bf16_t*)(p.ws + OFF_VCMPT) + (size_t)bg * 64 * 256;
    float mc = -1.0e30f, lc = 0.f;
    tile_gload(TRA, KC, VCT, 256, 0, tid);
    tile_sstore(TRA, KsB, VsB, tid);
    __syncthreads();
#pragma unroll 1
    for (int pass = 0; pass < 2; ++pass) {
      float inv = 0.f;
      if (pass == 1) {
        float lt = xhalf_sum(lc);
        inv = lt > 0.f ? 1.0f / lt : 0.f;
#pragma unroll
        for (int dt = 0; dt < 2; ++dt)
#pragma unroll
          for (int r = 0; r < 16; ++r) Of[dt][r] = 0.f;
      }
      float carryE = 0.f;
#pragma unroll 1
      for (int n = 0; n < nct; ++n) {
        const int it = pass * nct + n;
        const int buf = it & 1;
        const bool more = it + 1 < 2 * nct;
        if (more) tile_gload(TRA, KC, VCT, 256, (n + 1 < nct) ? n + 1 : 0, tid);
        const bf16_t* Ks = KsB + buf * KS_ELEMS; const bf16_t* Vs = VsB + buf * VS_ELEMS;
        f32x16 S[2];
        qk_tile(Ks, Qf, S, cl, h);
        const bool edge = (n * 64 + 63 >= 2 * qt - 1);
        if (pass == 0) {
          float mx = -1.0e30f;
          if (edge) {
#pragma unroll
            for (int kt = 0; kt < 2; ++kt)
#pragma unroll
              for (int r = 0; r < 16; ++r) {
                int c = n * 64 + kt * 32 + (r & 3) + 8 * (r >> 2) + 4 * h;
                S[kt][r] = (c * 16 + 31 <= tq) ? S[kt][r] : -1.0e30f;
              }
          }
#pragma unroll
          for (int kt = 0; kt < 2; ++kt)
#pragma unroll
            for (int r = 0; r < 16; ++r) mx = fmaxf(mx, S[kt][r]);
          mx = xhalf_max(mx);
          const float mn = fmaxf(mc, mx);
          lc *= ex2(mc - mn);
          mc = mn;
          float ps = 0.f;
          if (edge) {
#pragma unroll
            for (int kt = 0; kt < 2; ++kt)
#pragma unroll
              for (int r = 0; r < 16; ++r) {
                int c = n * 64 + kt * 32 + (r & 3) + 8 * (r >> 2) + 4 * h;
                ps += (c * 16 + 31 <= tq) ? ex2(S[kt][r] - mn) : 0.f;
              }
          } else {
#pragma unroll
            for (int kt = 0; kt < 2; ++kt)
#pragma unroll
              for (int r = 0; r < 16; ++r) ps += ex2(S[kt][r] - mn);
          }
          lc += ps;
        } else {
#pragma unroll
          for (int kt = 0; kt < 2; ++kt) {
            if (edge) {
#pragma unroll
              for (int r = 0; r < 16; ++r) {
                int c = n * 64 + kt * 32 + (r & 3) + 8 * (r >> 2) + 4 * h;
                S[kt][r] = (c * 16 + 31 <= tq) ? ex2(S[kt][r] - mc) * inv : 0.f;
              }
            } else {
#pragma unroll
              for (int r = 0; r < 16; ++r) S[kt][r] = ex2(S[kt][r] - mc) * inv;
            }
#pragma unroll
            for (int q4 = 0; q4 < 4; ++q4) {
              float G = (S[kt][4 * q4] + S[kt][4 * q4 + 1]) + (S[kt][4 * q4 + 2] + S[kt][4 * q4 + 3]);
              float pE = xhalf_other(S[kt][4 * q4 + 3], h);
              float add = h ? pE : carryE;
              carryE = pE;
              impS[(w * 32 + cl) * 65 + n * 16 + kt * 8 + 2 * q4 + h] = G + add;
            }
          }
          pv_tile(Vs, S, Of, cl, h);
        }
        if (more) tile_sstore(TRA, KsB + (buf ^ 1) * KS_ELEMS, VsB + (buf ^ 1) * VS_ELEMS, tid);
        __syncthreads();
      }
    }
    for (int n2 = nct * 16 + h; n2 < 64; n2 += 2) impS[(w * 32 + cl) * 65 + n2] = 0.f;
  }
  __syncthreads();
  {
    int q = tid & 31, part = tid >> 5;
    int tqq = t0 + q, cur = tqq >> 6;
#pragma unroll
    for (int i = 0; i < 8; ++i) {
      int n = part * 8 + i;
      float v = (impS[(0 * 32 + q) * 65 + n] + impS[(1 * 32 + q) * 65 + n]) + (impS[(2 * 32 + q) * 65 + n] + impS[(3 * 32 + q) * 65 + n]);
      bool forced = (n == 0) | (n == cur) | (n == cur - 1);
      v = forced ? 1.0e4f : (n <= cur ? v : -1.0f);
      valS[q * 65 + n] = v;
    }
  }
  __syncthreads();
  {
    const int q = tid & 31, part = tid >> 5;
    float mv[8]; int cnt[8];
#pragma unroll
    for (int i = 0; i < 8; ++i) { mv[i] = valS[q * 65 + part * 8 + i]; cnt[i] = 0; }
#pragma unroll 4
    for (int n2 = 0; n2 < 64; ++n2) {
      const float v2 = valS[q * 65 + n2];
#pragma unroll
      for (int i = 0; i < 8; ++i) cnt[i] += (v2 > mv[i] || (v2 == mv[i] && n2 < part * 8 + i)) ? 1 : 0;
    }
    unsigned bits = 0;
#pragma unroll
    for (int i = 0; i < 8; ++i) bits |= (cnt[i] < 16 ? 1u : 0u) << i;
    maskS[q * 8 + part] = (unsigned char)bits;
  }
  __syncthreads();
  const unsigned long long selmask = *(const unsigned long long*)(maskS + cl * 8);
  unsigned long long umask = selmask;
#pragma unroll
  for (int o = 16; o >= 1; o >>= 1) {
    unsigned lo = __shfl_xor((unsigned)umask, o), hi = __shfl_xor((unsigned)(umask >> 32), o);
    umask |= ((unsigned long long)hi << 32) | lo;
  }
  umask = ((unsigned long long)__builtin_amdgcn_readfirstlane((unsigned)(umask >> 32)) << 32) | (unsigned)__builtin_amdgcn_readfirstlane((unsigned)umask);
  const int cur = t0 >> 6;
  float* stash = impS;
  {
    const float g0 = GLV(0);
#pragma unroll
    for (int dt = 0; dt < 2; ++dt)
#pragma unroll
      for (int r = 0; r < 16; ++r) stash[(dt * 16 + r) * 256 + tid] = Of[dt][r] * g0;
  }
#pragma unroll
  for (int kk = 0; kk < 4; ++kk) Qf[kk] = *(const bf16x8*)((const bf16_t*)(oo + OO_QR) + qoff + kk * 16);
  {
    f32x16 O[2];
    float ms, ls;
    int sel_reps = 1 + (PROBE_DUP == 10 ? 1 : 0); asm volatile("" : "+s"(sel_reps));
#pragma unroll 1
    for (int rep = 0; rep < sel_reps; ++rep) {
#pragma unroll
    for (int dt = 0; dt < 2; ++dt)
#pragma unroll
      for (int r = 0; r < 16; ++r) O[dt][r] = 0.f;
    ms = -1.0e30f; ls = 0.f;
    const bf16_t* KS = (const bf16_t*)(oo + OO_KS) + (size_t)bg * T_ * 64;
    const bf16_t* VST = (const bf16_t*)(oo + OO_VST) + (size_t)bg * 64 * T_;
    unsigned long long rem = (cur > 0) ? (umask & ((1ull << cur) - 1ull)) : 0ull;
    int n = cur, it = 0;
    tile_gload(TRA, KS, VST, T_, n, tid);
    tile_sstore(TRA, KsB, VsB, tid);
    __syncthreads();
#pragma unroll 1
    while (true) {
      const int buf = it & 1;
      int nn = -1;
      if (rem != 0ull) { nn = 63 - __builtin_clzll(rem); rem &= ~(1ull << nn); }
      if (nn >= 0) tile_gload(TRA, KS, VST, T_, nn, tid);
      const bf16_t* Ks = KsB + buf * KS_ELEMS; const bf16_t* Vs = VsB + buf * VS_ELEMS;
      const bool bit = (selmask >> n) & 1ull;
      {
        auto valid = [&](int kt, int r) { int key = n * 64 + kt * 32 + (r & 3) + 8 * (r >> 2) + 4 * h; return key <= tq; };
        attn_tile64(Ks, Vs, Qf, O, ms, ls, bit, n == cur, valid, cl, h);
      }
      if (nn >= 0) tile_sstore(TRA, KsB + (buf ^ 1) * KS_ELEMS, VsB + (buf ^ 1) * VS_ELEMS, tid);
      __syncthreads();
      if (nn < 0) break;
      n = nn; ++it;
    }
    }
    ls = xhalf_sum(ls);
    const float g1 = GLV(1);
    float inv = ls > 0.f ? 1.0f / ls : 0.f;
#pragma unroll
    for (int dt = 0; dt < 2; ++dt)
#pragma unroll
      for (int r = 0; r < 16; ++r) stash[(dt * 16 + r) * 256 + tid] += O[dt][r] * (inv * g1);
  }
  {
    f32x16 O[2];
#pragma unroll
    for (int dt = 0; dt < 2; ++dt)
#pragma unroll
      for (int r = 0; r < 16; ++r) O[dt][r] = 0.f;
    float mw = -1.0e30f, lw = 0.f;
    const bf16_t* KW = (const bf16_t*)(oo + OO_KW) + (size_t)bg * T_ * 64;
    const bf16_t* VWT = (const bf16_t*)(oo + OO_VWT) + (size_t)bg * 64 * T_;
    const int nlo = (t0 - 511) > 0 ? ((t0 - 511) >> 6) : 0;
    int it = 0;
    tile_gload(TRA, KW, VWT, T_, cur, tid);
    tile_sstore(TRA, KsB, VsB, tid);
    __syncthreads();
#pragma unroll 1
    for (int n = cur; n >= nlo; --n, ++it) {
      const int buf = it & 1;
      if (n > nlo) tile_gload(TRA, KW, VWT, T_, n - 1, tid);
      const bf16_t* Ks = KsB + buf * KS_ELEMS; const bf16_t* Vs = VsB + buf * VS_ELEMS;
      const bool edge = (n == cur) || (n * 64 <= t0 + 31 - 512);
      {
        auto valid = [&](int kt, int r) { int key = n * 64 + kt * 32 + (r & 3) + 8 * (r >> 2) + 4 * h; return key <= tq && key > tq - 512; };
        attn_tile64(Ks, Vs, Qf, O, mw, lw, true, edge, valid, cl, h);
      }
      if (n > nlo) tile_sstore(TRA, KsB + (buf ^ 1) * KS_ELEMS, VsB + (buf ^ 1) * VS_ELEMS, tid);
      __syncthreads();
    }
    lw = xhalf_sum(lw);
    const float g2 = GLV(2);
    float inv = lw > 0.f ? 1.0f / lw : 0.f;
#pragma unroll
    for (int dt = 0; dt < 2; ++dt)
#pragma unroll
      for (int r = 0; r < 16; ++r) O[dt][r] = stash[(dt * 16 + r) * 256 + tid] + O[dt][r] * (inv * g2);
  {
    f32x16 (&Of)[2] = O;
    const size_t base = ((size_t)(b * T_ + tq)) * 512 + hd * 64;
    const bf16_t* GN = (const bf16_t*)(p.ws + OFF_GN);
    bf16_t* ON = (bf16_t*)(p.ws + OFF_ONSA);
#pragma unroll
    for (int dt = 0; dt < 2; ++dt)
#pragma unroll
      for (int rq = 0; rq < 4; ++rq) {
        int d = dt * 32 + 8 * rq + 4 * h;
        uint2 gv = *(const uint2*)(GN + base + d);
        float ga = __uint_as_float(gv.x << 16), gb = __uint_as_float(gv.x & 0xffff0000u), gc = __uint_as_float(gv.y << 16), gd = __uint_as_float(gv.y & 0xffff0000u);
        uint2 wv;
        wv.x = pack2(Of[dt][rq * 4 + 0] * ga, Of[dt][rq * 4 + 1] * gb);
        wv.y = pack2(Of[dt][rq * 4 + 2] * gc, Of[dt][rq * 4 + 3] * gd);
        *(uint2*)(ON + base + d) = wv;
      }
  }
  }
}

struct LdS5CA {
  const bf16_t* u2; const bf16_t* sp; int g, m0, nk1;
  __device__ __forceinline__ uint4 operator()(int row, int it, int q) const {
    int r = m0 + row; int b = r >> 6, c = r & 63;
    if (it < nk1) return *(const uint4*)(u2 + ((size_t)(b * 32 + g) * T_ + c * 64) * 16 + it * 64 + q * 8);
    return *(const uint4*)(sp + ((size_t)g * 256 + r) * 128 + (it - nk1) * 64 + q * 8);
  }
};
struct LdS5CB {
  const bf16_t* kt; const bf16_t* wo; int g, n0, nk1;
  __device__ __forceinline__ uint4 operator()(int row, int it, int q) const {
    int n = n0 + row; int i = n >> 4, co = n & 15;
    if (it < nk1) {
      int j = 4 * it + (q >> 1), ci0 = (q & 1) * 8;
      if (i >= j) return *(const uint4*)(kt + (((size_t)(g * 64 + (i - j)) * 16 + co) * 16 + ci0));
      return make_uint4(0, 0, 0, 0);
    }
    return *(const uint4*)(wo + ((size_t)g * 1024 + n) * 128 + (it - nk1) * 64 + q * 8);
  }
};

__device__ __forceinline__ void s5c_tile(const Params& p, int g, int rt, int nt, char* smem) {
  const int tid_ = otid(); const int lane = tid_ & 63, wid = tid_ >> 6, wr = wid >> 1, wc = wid & 1;
  int nk1 = 2 * nt + 2; if (nk1 > 16) nk1 = 16;
  AccT acc; zero_acc(acc);
  LdS5CA al{(const bf16_t*)(p.ws + OFF_U2), (const bf16_t*)(p.ws + OFF_SPREV), g, rt * 128, nk1};
  LdS5CB bl{(const bf16_t*)(p.ws + OFF_KT), (const bf16_t*)(p.ws + OFF_WOUT5), g, nt * 128, nk1};
  gemm_mainloop(acc, al, bl, nk1 + 2, (bf16_t*)smem);
  const bf16_t* U2 = (const bf16_t*)(p.ws + OFF_U2);
  bf16_t* Z = (bf16_t*)(p.ws + OFF_Z);
  float* Tl = (float*)smem;
  acc_to_lds<false>(acc, Tl, wr, wc, lane);
  __syncthreads();
#pragma unroll 1
  for (int i0 = 0; i0 < 8; i0 += 4) {
    uint4 uu[4]; float dd[4][8];
#pragma unroll
    for (int i = 0; i < 4; ++i) {
      const int id = tid_ + (i0 + i) * 256; const int row = id >> 4, c8 = id & 15;
      const int r = rt * 128 + row, n0 = nt * 128 + c8 * 8;
      const int b = r >> 6, c = r & 63, tl = c * 64 + (n0 >> 4), co0 = n0 & 15;
      uu[i] = *(const uint4*)(U2 + ((size_t)(b * 32 + g) * T_ + tl) * 16 + co0);
      ld8f(p.s5d + g * 16 + co0, dd[i]);
    }
#pragma unroll
    for (int i = 0; i < 4; ++i) {
      const int id = tid_ + (i0 + i) * 256; const int row = id >> 4, c8 = id & 15;
      const int r = rt * 128 + row, n0 = nt * 128 + c8 * 8;
      const int b = r >> 6, c = r & 63, tl = c * 64 + (n0 >> 4), co0 = n0 & 15;
      float v[8], u[8]; lds_chunk8(Tl, row, c8, v); unpack8(uu[i], u);
#pragma unroll
      for (int k = 0; k < 8; ++k) v[k] = geluf_(v[k] + dd[i][k] * u[k]);
      *(uint4*)(Z + ((size_t)(b * T_ + tl)) * 512 + g * 16 + co0) = pack8(v);
    }
  }
  __syncthreads();
}

__device__ __forceinline__ void phase4(const Params& p, char* smem) {
  const int n_nsa = 1024, n_s5 = 512;
#if MULTI_LAUNCH
  const int G = gridDim.x, bi = blockIdx.x;
  for (int L = bi; L < n_nsa; L += G) { const int qt = 127 - (L >> 3), bg = L & 7; nsa_unit(p, bg >> 1, bg & 1, qt, smem); }
  for (int v = bi; v < n_s5; v += G) { s5c_tile(p, (v >> 1) & 31, v & 1, 7 - (v >> 6), smem); }
#else
  const int tid = otid();
  const bool xm = (xinfo_s[1] == 8);
  const int xi = xinfo_s[0];
  unsigned* qbase = (unsigned*)(p.ws + OFF_BAR) + 3456 + 1024 + 16;
  unsigned* qa = qbase + 16 * (xm ? xi : 8);
  unsigned* qb = qbase + 16 * (9 + (xm ? xi : 8));
  const int totA = xm ? 128 : n_nsa, totB = xm ? 64 : n_s5;
  for (;;) {
    __syncthreads();
    if (tid == 0) q0_s = (int)__hip_atomic_fetch_add(qa, 1u, __ATOMIC_RELAXED, __HIP_MEMORY_SCOPE_AGENT);
    __syncthreads();
    const int L = q0_s;
    if (L >= totA) break;
    const int qt = xm ? (127 - L) : (127 - (L >> 3)), bg = xm ? xi : (L & 7);
    nsa_unit(p, bg >> 1, bg & 1, qt, smem);
  }
  for (;;) {
    __syncthreads();
    if (tid == 0) q0_s = (int)__hip_atomic_fetch_add(qb, 1u, __ATOMIC_RELAXED, __HIP_MEMORY_SCOPE_AGENT);
    __syncthreads();
    const int v = q0_s;
    if (v >= totB) break;
    const int nt = xm ? (7 - (v >> 3)) : (7 - (v >> 6));
    const int g = xm ? (4 * xi + ((v & 7) >> 1)) : ((v >> 1) & 31);
    s5c_tile(p, g, v & 1, nt, smem);
  }
#endif
}

__device__ __forceinline__ void phase5(const Params& p, char* smem) {
  const int tid_ = otid(); const int lane = tid_ & 63, wid = tid_ >> 6, wr = wid >> 1, wc = wid & 1, h = lane >> 5, cl = lane & 31;
  for (int i = 0;; ++i) {
    int rt, ct; if (!xcd_tile(i, 4, rt, ct)) break;
    AccT acc; zero_acc(acc);
    gemm_mainloop_dma(acc, (const bf16_t*)(p.ws + OFF_Z) + (size_t)rt * 128 * 512, 512, (const bf16_t*)(p.ws + OFF_WGLUT) + (size_t)ct * 128 * 512, 512, 8, (bf16_t*)smem);
    const bf16_t* Z = (const bf16_t*)(p.ws + OFF_Z); const bf16_t* GS = (const bf16_t*)(p.ws + OFF_GS);
    bf16_t* OS = (bf16_t*)(p.ws + OFF_OS5);
    float* Tl = (float*)smem;
    acc_to_lds<false>(acc, Tl, wr, wc, lane);
    __syncthreads();
#pragma unroll 1
    for (int i0 = 0; i0 < 8; i0 += 4) {
      uint4 zz[4], gg[4]; float bb[4][8];
#pragma unroll
      for (int i = 0; i < 4; ++i) {
        const int id = tid_ + (i0 + i) * 256; const int row = id >> 4, c8 = id & 15;
        const size_t o = (size_t)(rt * 128 + row) * 512 + ct * 128 + c8 * 8;
        zz[i] = *(const uint4*)(Z + o); gg[i] = *(const uint4*)(GS + o);
        ld8f(p.b_glu + ct * 128 + c8 * 8, bb[i]);
      }
#pragma unroll
      for (int i = 0; i < 4; ++i) {
        const int id = tid_ + (i0 + i) * 256; const int row = id >> 4, c8 = id & 15;
        const size_t o = (size_t)(rt * 128 + row) * 512 + ct * 128 + c8 * 8;
        float v[8], z[8], gs[8]; lds_chunk8(Tl, row, c8, v); unpack8(zz[i], z); unpack8(gg[i], gs);
#pragma unroll
        for (int k = 0; k < 8; ++k) v[k] = z[k] * sigmoidf_(v[k] + bb[i][k]) * gs[k];
        *(uint4*)(OS + o) = pack8(v);
      }
    }
    __syncthreads();
  }
}

__device__ __forceinline__ void phase6(const Params& p, char* smem) {
  float* Tl = (float*)smem;
  for (int i = 0;; ++i) {
    int rt, ct; if (!xcd_tile(i, 8, rt, ct)) break;
    const bf16_t* MGA = (const bf16_t*)(p.ws + OFF_MGA); const bf16_t* MGB = (const bf16_t*)(p.ws + OFF_MGB);
    bf16_t* MG = (bf16_t*)(p.ws + OFF_HN);
    AccT acc, acc2; zero_acc(acc); zero_acc(acc2);
    gemm_mainloop_dma2(acc, acc2, (const bf16_t*)(p.ws + OFF_ONSA) + (size_t)rt * 128 * 512, 512, (const bf16_t*)(p.ws + OFF_WAT) + (size_t)ct * 128 * 512, 512,
                       (const bf16_t*)(p.ws + OFF_OS5) + (size_t)rt * 128 * 512, 512, (const bf16_t*)(p.ws + OFF_WBT) + (size_t)ct * 128 * 512, 512, 8, (bf16_t*)smem);
    const int tid_ = otid(); const int lane = tid_ & 63, wid = tid_ >> 6, wr = wid >> 1, wc = wid & 1;
    uint4 hold[8];
    {
      acc_to_lds<false>(acc, Tl, wr, wc, lane);
      __syncthreads();
#pragma unroll
      for (int hb = 0; hb < 2; ++hb) {
        if (hb) asm volatile("" ::: "memory");
        uint4 mg[4];
#pragma unroll
        for (int k = 0; k < 4; ++k) {
          const int id = tid_ + (hb * 4 + k) * 256; const int row = id >> 4, c8 = id & 15;
          mg[k] = *(const uint4*)(MGA + (size_t)(rt * 128 + row) * 1024 + ct * 128 + c8 * 8);
        }
#pragma unroll
        for (int k = 0; k < 4; ++k) {
          const int id = tid_ + (hb * 4 + k) * 256; const int row = id >> 4, c8 = id & 15;
          float v[8], m[8]; lds_chunk8(Tl, row, c8, v); unpack8(mg[k], m);
#pragma unroll
          for (int e = 0; e < 8; ++e) v[e] *= m[e];
          hold[hb * 4 + k] = pack8(v);
        }
      }
      __syncthreads();
    }
    {
      acc_to_lds<false>(acc2, Tl, wr, wc, lane);
      __syncthreads();
#pragma unroll
      for (int hb = 0; hb < 2; ++hb) {
        if (hb) asm volatile("" ::: "memory");
        uint4 mg[4];
#pragma unroll
        for (int k = 0; k < 4; ++k) {
          const int id = tid_ + (hb * 4 + k) * 256; const int row = id >> 4, c8 = id & 15;
          mg[k] = *(const uint4*)(MGB + (size_t)(rt * 128 + row) * 1024 + ct * 128 + c8 * 8);
        }
#pragma unroll
        for (int k = 0; k < 4; ++k) {
          const int id = tid_ + (hb * 4 + k) * 256; const int row = id >> 4, c8 = id & 15;
          float v[8], m[8], hv[8]; lds_chunk8(Tl, row, c8, v); unpack8(mg[k], m); unpack8(hold[hb * 4 + k], hv);
#pragma unroll
          for (int e = 0; e < 8; ++e) v[e] = hv[e] + v[e] * m[e];
          *(uint4*)(MG + (size_t)(rt * 128 + row) * 1024 + ct * 128 + c8 * 8) = pack8(v);
        }
      }
      __syncthreads();
    }
  }
}

__device__ __forceinline__ void phase7(const Params& p, char* smem) {
  const int tid_ = otid(); const int lane = tid_ & 63, wid = tid_ >> 6, wr = wid >> 1, wc = wid & 1;
  float* Tl = (float*)smem;
  for (int i = 0;; ++i) {
    int rt, ct; if (!xcd_tile(i, 8, rt, ct)) break;
    AccT acc; zero_acc(acc);
    gemm_mainloop_dma(acc, (const bf16_t*)(p.ws + OFF_HN) + (size_t)rt * 128 * 1024, 1024, (const bf16_t*)(p.ws + OFF_WOUTT) + (size_t)ct * 128 * 1024, 1024, 16, (bf16_t*)smem);
    float* RSS = (float*)(p.ws + OFF_RSS);
    acc_to_lds<false>(acc, Tl, wr, wc, lane);
    __syncthreads();
#pragma unroll 1
    for (int i0 = 0; i0 < 8; i0 += 4) {
      float xx[4][8];
#pragma unroll
      for (int k = 0; k < 4; ++k) {
        const int id = tid_ + (i0 + k) * 256; const int row = id >> 4, c8 = id & 15;
        ld8f(p.x + (size_t)(rt * 128 + row) * 1024 + ct * 128 + c8 * 8, xx[k]);
      }
#pragma unroll
      for (int k = 0; k < 4; ++k) {
        const int id = tid_ + (i0 + k) * 256; const int row = id >> 4, c8 = id & 15;
        float v[8]; lds_chunk8(Tl, row, c8, v);
        float ss = 0.f;
#pragma unroll
        for (int e = 0; e < 8; ++e) { v[e] += xx[k][e]; ss += v[e] * v[e]; }
        st8f(p.out + (size_t)(rt * 128 + row) * 1024 + ct * 128 + c8 * 8, v);
        ss += __shfl_xor(ss, 1); ss += __shfl_xor(ss, 2); ss += __shfl_xor(ss, 4); ss += __shfl_xor(ss, 8);
        if (c8 == 0) RSS[(size_t)(rt * 128 + row) * 16 + ct] = ss;
      }
    }
    __syncthreads();
  }
}

__device__ __forceinline__ void phase8(const Params& p) {
  const int tid_ = otid(); const int lane = tid_ & 63, wid = tid_ >> 6;
  for (int u = blockIdx.x; u < 1024; u += gridDim.x) {
    const size_t row0 = (size_t)u * 16 + wid * 4;
    float4 v[4][4]; float sc[4];
#pragma unroll
    for (int r = 0; r < 4; ++r) {
      const float4* o = (const float4*)(p.out + (row0 + r) * DM);
#pragma unroll
      for (int i = 0; i < 4; ++i) v[r][i] = o[lane + i * 64];
    }
    float4 g[4];
#pragma unroll
    for (int i = 0; i < 4; ++i) g[i] = ((const float4*)p.final_g)[lane + i * 64];
#pragma unroll
    for (int r = 0; r < 4; ++r) {
      const float4* rs = (const float4*)((const float*)(p.ws + OFF_RSS) + (row0 + r) * 16);
      const float4 a = rs[0], b = rs[1];
      const float ss = ((a.x + a.y) + (a.z + a.w)) + ((b.x + b.y) + (b.z + b.w));
      sc[r] = rsqrtf(ss * (1.0f / DM) + 1.0e-6f);
    }
#pragma unroll
    for (int r = 0; r < 4; ++r) {
      float4* o = (float4*)(p.out + (row0 + r) * DM);
#pragma unroll
      for (int i = 0; i < 4; ++i) {
        float4 w = v[r][i];
        w.x *= sc[r] * g[i].x; w.y *= sc[r] * g[i].y; w.z *= sc[r] * g[i].z; w.w *= sc[r] * g[i].w;
        o[lane + i * 64] = w;
      }
    }
  }
}

#define XB_TMO      128
#define XB_XCNT(j)  (256  + 64 * (j))
#define XB_XSUB(j)  (1280 + 64 * (j))
#define XB_XGEN(j)  (2304 + 64 * (j))
#define XB_TOP      3328
#define XB_TOPGEN   3392
#define XCD_BAR_WORDS 3456
#define XB_SPIN_CAP (1u << 18)
#define LAS __attribute__((address_space(3)))
__device__ __forceinline__ unsigned xb_ld(unsigned* p)              { return __hip_atomic_load(p, __ATOMIC_RELAXED, __HIP_MEMORY_SCOPE_AGENT); }
__device__ __forceinline__ unsigned xb_add(unsigned* p, unsigned v) { return __hip_atomic_fetch_add(p, v, __ATOMIC_RELAXED, __HIP_MEMORY_SCOPE_AGENT); }
__device__ __forceinline__ unsigned xb_xcc_id() { return (unsigned)__builtin_amdgcn_s_getreg((3 << 11) | 20) & 0xFu; }
#define XB_SPIN(cond, bar) do { unsigned _sp = 0; while (cond) { __builtin_amdgcn_s_sleep(1); \
    if ((++_sp & 255u) == 0u) { if (xb_ld(&(bar)[XB_TMO])) break; if (_sp > XB_SPIN_CAP) { atomicAdd(&(bar)[XB_TMO], 1u); break; } } } } while (0)
struct XcdBarrier { unsigned* bar; unsigned x; volatile LAS unsigned* st; };
__device__ __forceinline__ XcdBarrier xcd_barrier_post(unsigned* bar, volatile LAS unsigned* st) {
    XcdBarrier b; b.bar = bar; b.x = xb_xcc_id(); b.st = st;
    if (threadIdx.x == 0) (void)xb_add(&bar[XB_XCNT(b.x)], 1u);
    return b;
}
__device__ __forceinline__ void xcd_barrier_complete(unsigned* bar, unsigned x, unsigned& nloc, unsigned& nx) {
    const unsigned G = gridDim.x * gridDim.y * gridDim.z;
    unsigned sum, cnt, mine, sp = 0u;
    for (;;) {
        sum = 0u; cnt = 0u; mine = 0u;
#pragma unroll
        for (unsigned j = 0; j < 16; ++j) { const unsigned c = xb_ld(&bar[XB_XCNT(j)]); sum += c; cnt += (c > 0u) ? 1u : 0u; mine = (j == x) ? c : mine; }
        if (sum == G) break;
        __builtin_amdgcn_s_sleep(1);
        if ((++sp & 255u) == 0u) { if (xb_ld(&bar[XB_TMO])) break; if (sp > XB_SPIN_CAP) { atomicAdd(&bar[XB_TMO], 1u); break; } }
    }
    nloc = mine > 0u ? mine : 1u; nx = cnt > 0u ? cnt : 1u;
}
__device__ __forceinline__ void xcd_barrier(unsigned* bar, unsigned x, volatile LAS unsigned* st) {
    asm volatile("s_waitcnt vmcnt(0)" ::: "memory");
    __syncthreads();
    if (threadIdx.x == 0) {
        __builtin_amdgcn_s_waitcnt(0);
        unsigned nloc = st[0], nx = st[1];
        if (nloc == 0u) { xcd_barrier_complete(bar, x, nloc, nx); st[0] = nloc; st[1] = nx; }
        const unsigned old = xb_add(&bar[XB_XSUB(x)], 1u);
        const unsigned gen = old / nloc;
        if (old + 1u == (gen + 1u) * nloc) {
            __builtin_amdgcn_fence(__ATOMIC_RELEASE, "agent");
            asm volatile("s_waitcnt vmcnt(0)" ::: "memory");
            const unsigned og = xb_add(&bar[XB_TOP], 1u);
            const unsigned tg = og / nx;
            if (og + 1u == (tg + 1u) * nx) xb_add(&bar[XB_TOPGEN], 1u);
            else XB_SPIN(xb_ld(&bar[XB_TOPGEN]) == tg, bar);
            __builtin_amdgcn_fence(__ATOMIC_ACQUIRE, "agent");
            xb_add(&bar[XB_XGEN(x)], 1u);
            asm volatile("s_waitcnt vmcnt(0)" ::: "memory");
        } else {
            XB_SPIN(xb_ld(&bar[XB_XGEN(x)]) == gen, bar);
            __builtin_amdgcn_fence(__ATOMIC_ACQUIRE, "agent");
            asm volatile("s_waitcnt vmcnt(0)" ::: "memory");
        }
    }
    __syncthreads();
}

constexpr int SMEM_BYTES = NSA_SMEM_BYTES > GEMM_SMEM_BYTES ? NSA_SMEM_BYTES : GEMM_SMEM_BYTES;

template <int PH>
__global__ void __launch_bounds__(NTHR, 2) k_phase(Params p) {
  __shared__ __attribute__((aligned(16))) char smem[SMEM_BYTES];
  if (PH == 0) phase0(p, smem);
  if (PH == 1) phase1(p, smem);
  if (PH == 2) phase2(p, smem);
  if (PH == 3) phase3(p, smem);
  if (PH == 4) phase4(p, smem);
  if (PH == 5) phase5(p, smem);
  if (PH == 6) phase6(p, smem);
  if (PH == 7) phase7(p, smem);
  if (PH == 8) phase8(p);
}

__device__ __forceinline__ Params fresh(const Params& p) { Params q = p; asm volatile("" : "+s"(q.ws), "+s"(q.out)); return q; }
#if !MULTI_LAUNCH
#define GSYNC() xcd_barrier(bar, xb.x, xb.st)
__global__ void __launch_bounds__(NTHR, 2) k_mega(Params p) {
  __shared__ __attribute__((aligned(16))) char smem[SMEM_BYTES];
  __shared__ uint4 xb_words;
  unsigned* bar = (unsigned*)(p.ws + OFF_BAR);
  if (threadIdx.x == 0) xb_words = make_uint4(0u, 0u, 0u, 0u);
  __syncthreads();
  XcdBarrier xb = xcd_barrier_post(bar, (volatile LAS unsigned*)&xb_words);
  if (threadIdx.x == 0) xinfo_s[2] = (int)xb_add(&bar[XCD_BAR_WORDS + 64 * xb.x], 1u);
  if (p.ws == nullptr) cg::this_grid().sync();
  { int reps = 1 + (PROBE_DUP == 0 ? 1 : 0); asm volatile("" : "+s"(reps)); for (int r = 0; r < reps; ++r) { const Params q = fresh(p); phase0(q, smem); GSYNC(); } }
  if (threadIdx.x == 0) {
    int nx = 0, xi = 0, nloc = 1;
    for (unsigned j = 0; j < 16; ++j) {
      const int c = (int)xb_ld(&bar[XCD_BAR_WORDS + 64 * j]);
      nx += (c > 0) ? 1 : 0; xi += (c > 0 && j < xb.x) ? 1 : 0; if (j == xb.x) nloc = c > 0 ? c : 1;
    }
    xinfo_s[0] = xi; xinfo_s[1] = nx > 0 ? nx : 1; xinfo_s[3] = nloc;
  }
  __syncthreads();
  { int reps = 1 + (PROBE_DUP == 1 ? 1 : 0); asm volatile("" : "+s"(reps)); for (int r = 0; r < reps; ++r) { const Params q = fresh(p); phase1(q, smem); GSYNC(); } }
  { int reps = 1 + (PROBE_DUP == 2 ? 1 : 0); asm volatile("" : "+s"(reps)); for (int r = 0; r < reps; ++r) { const Params q = fresh(p); phase2(q, smem); GSYNC(); } }
  { int reps = 1 + (PROBE_DUP == 3 ? 1 : 0); asm volatile("" : "+s"(reps)); for (int r = 0; r < reps; ++r) { const Params q = fresh(p); phase3(q, smem); GSYNC(); } }
  { int reps = 1 + (PROBE_DUP == 4 ? 1 : 0); asm volatile("" : "+s"(reps)); for (int r = 0; r < reps; ++r) { const Params q = fresh(p); phase4(q, smem); GSYNC(); } }
  { int reps = 1 + (PROBE_DUP == 5 ? 1 : 0); asm volatile("" : "+s"(reps)); for (int r = 0; r < reps; ++r) { const Params q = fresh(p); phase5(q, smem); GSYNC(); } }
  { int reps = 1 + (PROBE_DUP == 6 ? 1 : 0); asm volatile("" : "+s"(reps)); for (int r = 0; r < reps; ++r) { const Params q = fresh(p); phase6(q, smem); GSYNC(); } }
  { int reps = 1 + (PROBE_DUP == 7 ? 1 : 0); asm volatile("" : "+s"(reps)); for (int r = 0; r < reps; ++r) { const Params q = fresh(p); phase7(q, smem); GSYNC(); } }
  { const Params q = fresh(p); phase8(q); }
}
#endif

extern "C" void kernel_launch(void* const* d_in, const int* in_sizes, int n_in, void* d_out, int out_size, void* d_ws, size_t ws_size,
                              hipStream_t stream) {
  Params p{};
  const float** f = (const float**)&p;
  for (int i = 0; i < 23; ++i) f[i] = (const float*)d_in[i];
  p.out = (float*)d_out;
  p.ws = (char*)d_ws;
#if MULTI_LAUNCH
  const int G = 1024;
  k_phase<0><<<G, NTHR, 0, stream>>>(p);
  k_phase<1><<<G, NTHR, 0, stream>>>(p);
  k_phase<2><<<G, NTHR, 0, stream>>>(p);
  k_phase<3><<<G, NTHR, 0, stream>>>(p);
  k_phase<4><<<G, NTHR, 0, stream>>>(p);
  k_phase<5><<<G, NTHR, 0, stream>>>(p);
  k_phase<6><<<G, NTHR, 0, stream>>>(p);
  k_phase<7><<<G, NTHR, 0, stream>>>(p);
  k_phase<8><<<G, NTHR, 0, stream>>>(p);
#else
  static int grid_blocks = 0;
  if (!grid_blocks) {
    int dev = 0, cus = 0, per_cu = 0;
    hipGetDevice(&dev);
    hipDeviceGetAttribute(&cus, hipDeviceAttributeMultiprocessorCount, dev);
    hipOccupancyMaxActiveBlocksPerMultiprocessor(&per_cu, k_mega, NTHR, 0);
    if (per_cu > 2) per_cu = 2;
    grid_blocks = cus * per_cu;
  }
  (void)hipMemsetAsync((char*)d_ws + OFF_BAR, 0, (XCD_BAR_WORDS + 1024 + 16 + 19 * 16) * sizeof(unsigned), stream);
  void* args[] = {&p};
  hipError_t e = hipLaunchCooperativeKernel((void*)k_mega, dim3(grid_blocks), dim3(NTHR), args, 0, stream);
  if (e != hipSuccess) fprintf(stderr, "cooperative launch failed: %s (grid %d)\n", hipGetErrorString(e), grid_blocks);
#endif
}
```

```cpp
#include <hip/hip_runtime.h>
#include <hip/hip_cooperative_groups.h>
#include <stdint.h>
#include <stdio.h>
namespace cg = cooperative_groups;

#ifndef PROBE_DUP
#define PROBE_DUP -1
#endif
#ifndef MULTI_LAUNCH
#define MULTI_LAUNCH 0
#endif

typedef unsigned short bf16_t;
typedef short bf16x8 __attribute__((ext_vector_type(8)));
typedef short bf16x4 __attribute__((ext_vector_type(4)));
typedef float f32x16 __attribute__((ext_vector_type(16)));
typedef float f32x4 __attribute__((ext_vector_type(4)));
typedef uint32_t u32x4 __attribute__((ext_vector_type(4)));
typedef f32x4 AccT[4][4];

constexpr int T_ = 4096, NT = 16384, DM = 1024;
constexpr int NTHR = 256;
constexpr size_t MB = 1u << 20;
constexpr size_t OFF_HN = 0;
constexpr size_t OFF_WINT = 32 * MB;
constexpr size_t OFF_GN = 42 * MB;
constexpr size_t OFF_U2 = 58 * MB;
constexpr size_t OFF_GS = 74 * MB;
constexpr size_t OFF_MGA = 90 * MB;
constexpr size_t OFF_MGB = 122 * MB;
constexpr size_t OFF_GL = 154 * MB;
constexpr size_t OFF_ONSA = 156 * MB;
constexpr size_t OFF_Z = 172 * MB;
constexpr size_t OFF_OS5 = 188 * MB;
constexpr size_t OFF_W1KT = 204 * MB;
constexpr size_t OFF_W1VT = 205 * MB;
constexpr size_t OFF_W2KT = 206 * MB;
constexpr size_t OFF_W2VT = 206 * MB + 65536;
constexpr size_t OFF_BIAS1 = 206 * MB + 131072;
constexpr size_t OFF_AL = 206 * MB + 131072 + 4096;
constexpr size_t OFF_WGLUT = 207 * MB;
constexpr size_t OFF_WAT = 208 * MB;
constexpr size_t OFF_WBT = 209 * MB;
constexpr size_t OFF_WOUTT = 210 * MB;
constexpr size_t OFF_ROPE = 212 * MB;
constexpr size_t OFF_KT = 213 * MB;
constexpr size_t OFF_WIN5 = 214 * MB;
constexpr size_t OFF_WOUT5 = 222 * MB;
constexpr size_t OFF_H1 = 230 * MB;
constexpr size_t OFF_KCMP = 232 * MB;
constexpr size_t OFF_VCMPT = 232 * MB + 262144;
constexpr size_t OFF_E = 233 * MB;
constexpr size_t OFF_SPREV = 241 * MB;
constexpr size_t OFF_BAR = 244 * MB;
constexpr size_t OFF_RSS = 243 * MB;
constexpr size_t OFF_HP = 188 * MB;
constexpr size_t OFF_BP = 206 * MB + 262144;
constexpr size_t OFF_E2 = 233 * MB;
constexpr size_t OO_Q = 0, OO_QR = 16 * MB, OO_KC = 32 * MB, OO_VC = 36 * MB, OO_KS = 40 * MB, OO_KW = 44 * MB, OO_VST = 48 * MB, OO_VWT = 52 * MB;

struct Params {
  const float *x, *norm_g, *w_in, *pos_k, *pos_v, *w1k, *w2k, *w1v, *w2v, *lam_re, *lam_im, *log_dt, *b_re, *b_im, *c_re, *c_im,
      *s5d, *w_glu, *b_glu, *w_pa, *w_pb, *w_out, *final_g;
  float* out;
  char* ws;
};

__device__ __forceinline__ bf16_t f2bf(float f) {
  uint32_t u = __float_as_uint(f);
  u += 0x7fffu + ((u >> 16) & 1u);
  return (bf16_t)(u >> 16);
}
__device__ __forceinline__ float bf2f(bf16_t h) { return __uint_as_float(((uint32_t)h) << 16); }
__device__ __forceinline__ uint32_t pack2(float a, float b) { return (uint32_t)f2bf(a) | ((uint32_t)f2bf(b) << 16); }
__device__ __forceinline__ float rcpf_(float v) { return __builtin_amdgcn_rcpf(v); }
__device__ __forceinline__ float sigmoidf_(float v) { return rcpf_(1.0f + __builtin_amdgcn_exp2f(-1.4426950408889634f * v)); }
__device__ __forceinline__ float siluf_(float v) { return v * sigmoidf_(v); }
__device__ __forceinline__ float geluf_(float v) {
  float u = 0.7978845608028654f * (v + 0.044715f * v * v * v);
  return v * rcpf_(1.0f + __builtin_amdgcn_exp2f(-2.8853900817779268f * u));
}
typedef float f32x2_ __attribute__((ext_vector_type(2)));
typedef __bf16 bf16x2_ __attribute__((ext_vector_type(2)));
__device__ __forceinline__ uint32_t cvt_pk_bf16(float lo, float hi) { f32x2_ v; v.x = lo; v.y = hi; return __builtin_bit_cast(uint32_t, __builtin_convertvector(v, bf16x2_)); }
__device__ __forceinline__ uint4 pack8(const float (&v)[8]) { return make_uint4(cvt_pk_bf16(v[0], v[1]), cvt_pk_bf16(v[2], v[3]), cvt_pk_bf16(v[4], v[5]), cvt_pk_bf16(v[6], v[7])); }
__device__ __forceinline__ void unpack8(uint4 w, float (&v)[8]) {
  v[0] = __uint_as_float(w.x << 16); v[1] = __uint_as_float(w.x & 0xffff0000u); v[2] = __uint_as_float(w.y << 16); v[3] = __uint_as_float(w.y & 0xffff0000u);
  v[4] = __uint_as_float(w.z << 16); v[5] = __uint_as_float(w.z & 0xffff0000u); v[6] = __uint_as_float(w.w << 16); v[7] = __uint_as_float(w.w & 0xffff0000u);
}
__device__ __forceinline__ int otid() { int t = threadIdx.x; asm volatile("" : "+v"(t)); return t; }
__device__ __forceinline__ float ex2(float v) { return __builtin_amdgcn_exp2f(v); }

__device__ __forceinline__ void sincos_d(double a, double& s, double& c) {
  double n = rint(a * 0.6366197723675814);
  double r = fma(-n, 1.5707963267948966, a);
  r = fma(-n, 6.123233995736766e-17, r);
  int q = ((int)(long long)n) & 3;
  double r2 = r * r;
  double sp = r * (1.0 + r2 * (-1.0 / 6.0 + r2 * (1.0 / 120.0 + r2 * (-1.0 / 5040.0 + r2 * (1.0 / 362880.0 + r2 * (-1.0 / 39916800.0 + r2 * (1.0 / 6227020800.0)))))));
  double cp = 1.0 + r2 * (-0.5 + r2 * (1.0 / 24.0 + r2 * (-1.0 / 720.0 + r2 * (1.0 / 40320.0 + r2 * (-1.0 / 3628800.0 + r2 * (1.0 / 479001600.0 + r2 * (-1.0 / 87178291200.0)))))));
  if (q == 0) { s = sp; c = cp; }
  else if (q == 1) { s = cp; c = -sp; }
  else if (q == 2) { s = -sp; c = -cp; }
  else { s = -cp; c = sp; }
}

constexpr int LDS_STRIDE = 72;
constexpr int TILE_ELEMS = 128 * LDS_STRIDE;
constexpr int GEMM_SMEM_BYTES = 4 * TILE_ELEMS * 2;

__device__ __forceinline__ void gemm_compute(AccT& acc, const bf16_t* smem, int buf, int wr, int wc, int lane) {
  const bf16_t* sa = smem + buf * TILE_ELEMS + (wr * 64 + (lane & 15)) * LDS_STRIDE + (lane >> 4) * 8;
  const bf16_t* sb = smem + (2 + buf) * TILE_ELEMS + (wc * 64 + (lane & 15)) * LDS_STRIDE + (lane >> 4) * 8;
#pragma unroll
  for (int ks = 0; ks < 2; ++ks) {
    bf16x8 fa[4], fb[4];
#pragma unroll
    for (int m = 0; m < 4; ++m) { fa[m] = *(const bf16x8*)(sa + m * 16 * LDS_STRIDE + ks * 32); fb[m] = *(const bf16x8*)(sb + m * 16 * LDS_STRIDE + ks * 32); }
#pragma unroll
    for (int m = 0; m < 4; ++m)
#pragma unroll
      for (int n = 0; n < 4; ++n) acc[m][n] = __builtin_amdgcn_mfma_f32_16x16x32_bf16(fb[n], fa[m], acc[m][n], 0, 0, 0);
  }
}
template <class AL, class BL>
__device__ __forceinline__ void gemm_mainloop(AccT& acc, const AL& al, const BL& bl, int nk, bf16_t* smem) {
  const int tid = otid(), lane = tid & 63, wid = tid >> 6, wr = wid >> 1, wc = wid & 1;
  uint4 ra[4], rb[4];
#pragma unroll
  for (int i = 0; i < 4; ++i) { int id = tid + i * 256; ra[i] = al(id >> 3, 0, id & 7); rb[i] = bl(id >> 3, 0, id & 7); }
#pragma unroll
  for (int i = 0; i < 4; ++i) {
    int id = tid + i * 256; int row = id >> 3, q = id & 7;
    *(uint4*)(smem + row * LDS_STRIDE + q * 8) = ra[i];
    *(uint4*)(smem + 2 * TILE_ELEMS + row * LDS_STRIDE + q * 8) = rb[i];
  }
  __syncthreads();
#pragma unroll 1
  for (int it = 0; it < nk; ++it) {
    const int buf = it & 1;
    if (it + 1 < nk) {
#pragma unroll
      for (int i = 0; i < 4; ++i) { int id = tid + i * 256; ra[i] = al(id >> 3, it + 1, id & 7); rb[i] = bl(id >> 3, it + 1, id & 7); }
    }
    gemm_compute(acc, smem, buf, wr, wc, lane);
    if (it + 1 < nk) {
      const int nb = buf ^ 1;
#pragma unroll
      for (int i = 0; i < 4; ++i) {
        int id = tid + i * 256; int row = id >> 3, q = id & 7;
        *(uint4*)(smem + nb * TILE_ELEMS + row * LDS_STRIDE + q * 8) = ra[i];
        *(uint4*)(smem + (2 + nb) * TILE_ELEMS + row * LDS_STRIDE + q * 8) = rb[i];
      }
    }
    __syncthreads();
  }
}

constexpr int DMA_TILE = 128 * 64;
constexpr int RING_STAGE_BYTES = 16384;
template <bool DUAL>
__device__ __forceinline__ void gemm_ring_core(AccT& acc, AccT& acc2, const bf16_t* A, size_t lda, const bf16_t* B, size_t ldb,
                                               const bf16_t* A2, size_t lda2, const bf16_t* B2, size_t ldb2, int n1, int nk32, bf16_t* smem) {
  const int tid = otid(), lane = tid & 63, wid = tid >> 6, wr = wid >> 1, wc = wid & 1;
  const int prow = tid >> 2;
  const int pq = (tid & 3) ^ ((4 - ((prow >> 2) & 3)) & 3);
  const bf16_t* ga = A + (size_t)prow * lda + pq * 8;
  const bf16_t* gb = B + (size_t)prow * ldb + pq * 8;
  const bf16_t* ga2 = DUAL ? A2 + (size_t)prow * lda2 + pq * 8 : ga;
  const bf16_t* gb2 = DUAL ? B2 + (size_t)prow * ldb2 + pq * 8 : gb;
  char* lbase = (char*)smem + tid * 16;
#define RING_ISSUE(J) { const int stg_ = (J) & 3; const bool two_ = DUAL && (J) >= n1; \
    const bf16_t* pa_ = two_ ? ga2 + ((J) - n1) * 32 : ga + (J) * 32; const bf16_t* pb_ = two_ ? gb2 + ((J) - n1) * 32 : gb + (J) * 32; \
    const size_t la_ = two_ ? lda2 : lda, lb_ = two_ ? ldb2 : ldb; \
    _Pragma("unroll") for (int i_ = 0; i_ < 2; ++i_) { \
    __builtin_amdgcn_global_load_lds((const unsigned*)(pa_ + (size_t)(64 * i_) * la_), (unsigned*)(lbase + stg_ * RING_STAGE_BYTES + i_ * 4096), 16, 0, 0); \
    __builtin_amdgcn_global_load_lds((const unsigned*)(pb_ + (size_t)(64 * i_) * lb_), (unsigned*)(lbase + stg_ * RING_STAGE_BYTES + 8192 + i_ * 4096), 16, 0, 0); } }
  const int l15 = lane & 15, hq = lane >> 4;
  const int sw = (4 - (l15 >> 2)) & 3;
  const unsigned lds0 = (unsigned)(uintptr_t)(const __attribute__((address_space(3))) char*)smem;
  const unsigned offA = lds0 + (unsigned)((wr * 64 + l15) * 64 + ((hq ^ sw) << 4));
  const unsigned offB = lds0 + 8192u + (unsigned)((wc * 64 + l15) * 64 + ((hq ^ sw) << 4));
  asm volatile("s_waitcnt vmcnt(0)" ::: "memory");
  RING_ISSUE(0);
  if (nk32 > 1) RING_ISSUE(1);
  if (nk32 > 2) RING_ISSUE(2);
#pragma unroll 1
  for (int j = 0; j < nk32; ++j) {
    if (j + 2 < nk32) asm volatile("s_waitcnt vmcnt(8)" ::: "memory");
    else if (j + 1 < nk32) asm volatile("s_waitcnt vmcnt(4)" ::: "memory");
    else asm volatile("s_waitcnt vmcnt(0)" ::: "memory");
    asm volatile("s_waitcnt lgkmcnt(0)" ::: "memory");
    __builtin_amdgcn_s_barrier();
    const unsigned sa = offA + (unsigned)((j & 3) * RING_STAGE_BYTES), sb = offB + (unsigned)((j & 3) * RING_STAGE_BYTES);
    bf16x8 fa0, fa1, fa2, fa3, fb0, fb1, fb2, fb3;
    asm volatile(
        "ds_read_b128 %0, %8\n\t"
        "ds_read_b128 %1, %8 offset:1024\n\t"
        "ds_read_b128 %2, %8 offset:2048\n\t"
        "ds_read_b128 %3, %8 offset:3072\n\t"
        "ds_read_b128 %4, %9\n\t"
        "ds_read_b128 %5, %9 offset:1024\n\t"
        "ds_read_b128 %6, %9 offset:2048\n\t"
        "ds_read_b128 %7, %9 offset:3072"
        : "=&v"(fa0), "=&v"(fa1), "=&v"(fa2), "=&v"(fa3), "=&v"(fb0), "=&v"(fb1), "=&v"(fb2), "=&v"(fb3)
        : "v"(sa), "v"(sb)
        : "memory");
    if (j + 3 < nk32) RING_ISSUE(j + 3);
    asm volatile("s_waitcnt lgkmcnt(0)" : "+v"(fa0), "+v"(fa1), "+v"(fa2), "+v"(fa3), "+v"(fb0), "+v"(fb1), "+v"(fb2), "+v"(fb3) :: "memory");
    if (!DUAL || j < n1) {
    acc[0][0] = __builtin_amdgcn_mfma_f32_16x16x32_bf16(fb0, fa0, acc[0][0], 0, 0, 0);
    acc[0][1] = __builtin_amdgcn_mfma_f32_16x16x32_bf16(fb1, fa0, acc[0][1], 0, 0, 0);
    acc[0][2] = __builtin_amdgcn_mfma_f32_16x16x32_bf16(fb2, fa0, acc[0][2], 0, 0, 0);
    acc[0][3] = __builtin_amdgcn_mfma_f32_16x16x32_bf16(fb3, fa0, acc[0][3], 0, 0, 0);
    acc[1][0] = __builtin_amdgcn_mfma_f32_16x16x32_bf16(fb0, fa1, acc[1][0], 0, 0, 0);
    acc[1][1] = __builtin_amdgcn_mfma_f32_16x16x32_bf16(fb1, fa1, acc[1][1], 0, 0, 0);
    acc[1][2] = __builtin_amdgcn_mfma_f32_16x16x32_bf16(fb2, fa1, acc[1][2], 0, 0, 0);
    acc[1][3] = __builtin_amdgcn_mfma_f32_16x16x32_bf16(fb3, fa1, acc[1][3], 0, 0, 0);
    acc[2][0] = __builtin_amdgcn_mfma_f32_16x16x32_bf16(fb0, fa2, acc[2][0], 0, 0, 0);
    acc[2][1] = __builtin_amdgcn_mfma_f32_16x16x32_bf16(fb1, fa2, acc[2][1], 0, 0, 0);
    acc[2][2] = __builtin_amdgcn_mfma_f32_16x16x32_bf16(fb2, fa2, acc[2][2], 0, 0, 0);
    acc[2][3] = __builtin_amdgcn_mfma_f32_16x16x32_bf16(fb3, fa2, acc[2][3], 0, 0, 0);
    acc[3][0] = __builtin_amdgcn_mfma_f32_16x16x32_bf16(fb0, fa3, acc[3][0], 0, 0, 0);
    acc[3][1] = __builtin_amdgcn_mfma_f32_16x16x32_bf16(fb1, fa3, acc[3][1], 0, 0, 0);
    acc[3][2] = __builtin_amdgcn_mfma_f32_16x16x32_bf16(fb2, fa3, acc[3][2], 0, 0, 0);
    acc[3][3] = __builtin_amdgcn_mfma_f32_16x16x32_bf16(fb3, fa3, acc[3][3], 0, 0, 0);
    } else {
    acc2[0][0] = __builtin_amdgcn_mfma_f32_16x16x32_bf16(fb0, fa0, acc2[0][0], 0, 0, 0);
    acc2[0][1] = __builtin_amdgcn_mfma_f32_16x16x32_bf16(fb1, fa0, acc2[0][1], 0, 0, 0);
    acc2[0][2] = __builtin_amdgcn_mfma_f32_16x16x32_bf16(fb2, fa0, acc2[0][2], 0, 0, 0);
    acc2[0][3] = __builtin_amdgcn_mfma_f32_16x16x32_bf16(fb3, fa0, acc2[0][3], 0, 0, 0);
    acc2[1][0] = __builtin_amdgcn_mfma_f32_16x16x32_bf16(fb0, fa1, acc2[1][0], 0, 0, 0);
    acc2[1][1] = __builtin_amdgcn_mfma_f32_16x16x32_bf16(fb1, fa1, acc2[1][1], 0, 0, 0);
    acc2[1][2] = __builtin_amdgcn_mfma_f32_16x16x32_bf16(fb2, fa1, acc2[1][2], 0, 0, 0);
    acc2[1][3] = __builtin_amdgcn_mfma_f32_16x16x32_bf16(fb3, fa1, acc2[1][3], 0, 0, 0);
    acc2[2][0] = __builtin_amdgcn_mfma_f32_16x16x32_bf16(fb0, fa2, acc2[2][0], 0, 0, 0);
    acc2[2][1] = __builtin_amdgcn_mfma_f32_16x16x32_bf16(fb1, fa2, acc2[2][1], 0, 0, 0);
    acc2[2][2] = __builtin_amdgcn_mfma_f32_16x16x32_bf16(fb2, fa2, acc2[2][2], 0, 0, 0);
    acc2[2][3] = __builtin_amdgcn_mfma_f32_16x16x32_bf16(fb3, fa2, acc2[2][3], 0, 0, 0);
    acc2[3][0] = __builtin_amdgcn_mfma_f32_16x16x32_bf16(fb0, fa3, acc2[3][0], 0, 0, 0);
    acc2[3][1] = __builtin_amdgcn_mfma_f32_16x16x32_bf16(fb1, fa3, acc2[3][1], 0, 0, 0);
    acc2[3][2] = __builtin_amdgcn_mfma_f32_16x16x32_bf16(fb2, fa3, acc2[3][2], 0, 0, 0);
    acc2[3][3] = __builtin_amdgcn_mfma_f32_16x16x32_bf16(fb3, fa3, acc2[3][3], 0, 0, 0);
    }
  }
  asm volatile("s_waitcnt vmcnt(0) lgkmcnt(0)" ::: "memory");
  __syncthreads();
#undef RING_ISSUE
}

__device__ __forceinline__ void gemm_mainloop_dma(AccT& acc, const bf16_t* A, size_t lda, const bf16_t* B, size_t ldb, int nk, bf16_t* smem) {
  gemm_ring_core<false>(acc, acc, A, lda, B, ldb, A, lda, B, ldb, nk * 2, nk * 2, smem);
}
__device__ __forceinline__ void gemm_mainloop_dma2(AccT& acc, AccT& acc2, const bf16_t* A, size_t lda, const bf16_t* B, size_t ldb,
                                                   const bf16_t* A2, size_t lda2, const bf16_t* B2, size_t ldb2, int nk_each, bf16_t* smem) {
  gemm_ring_core<true>(acc, acc2, A, lda, B, ldb, A2, lda2, B2, ldb2, nk_each * 2, nk_each * 4, smem);
}

__device__ __forceinline__ void zero_acc(AccT& acc) {
#pragma unroll
  for (int m = 0; m < 4; ++m)
#pragma unroll
    for (int n = 0; n < 4; ++n) acc[m][n] = (f32x4){0.f, 0.f, 0.f, 0.f};
}

struct LdPlain {
  const bf16_t* base; size_t ld;
  __device__ __forceinline__ uint4 operator()(int row, int it, int q) const { return *(const uint4*)(base + (size_t)row * ld + it * 64 + q * 8); }
};

#define ACC_ROW(mi, reg, h) ((mi) * 32 + ((reg) & 3) + 8 * ((reg) >> 2) + 4 * (h))

constexpr int EP_STRIDE = 132;
template <bool TR>
__device__ __forceinline__ void acc_to_lds(const AccT& acc, float* Tl, int wr, int wc, int lane) {
  const int c4 = (lane >> 4) * 4, tl = lane & 15;
#pragma unroll
  for (int m = 0; m < 4; ++m)
#pragma unroll
    for (int n = 0; n < 4; ++n) {
      const int row = wr * 64 + m * 16 + tl, col = wc * 64 + n * 16 + c4;
      if (TR) {
#pragma unroll
        for (int reg = 0; reg < 4; ++reg) Tl[(col + reg) * EP_STRIDE + row] = acc[m][n][reg];
      } else {
        *(f32x4*)(Tl + row * EP_STRIDE + col) = acc[m][n];
      }
    }
}
__device__ __forceinline__ void lds_chunk8(const float* Tl, int row, int c8, float (&v)[8]) {
  const float4 a = *(const float4*)(Tl + row * EP_STRIDE + c8 * 8), b = *(const float4*)(Tl + row * EP_STRIDE + c8 * 8 + 4);
  v[0] = a.x; v[1] = a.y; v[2] = a.z; v[3] = a.w; v[4] = b.x; v[5] = b.y; v[6] = b.z; v[7] = b.w;
}
__device__ __forceinline__ void st8f(float* dst, const float (&v)[8]) {
  *(float4*)dst = make_float4(v[0], v[1], v[2], v[3]); *(float4*)(dst + 4) = make_float4(v[4], v[5], v[6], v[7]);
}
__device__ __forceinline__ void ld8f(const float* src, float (&v)[8]) {
  const float4 a = *(const float4*)src, b = *(const float4*)(src + 4);
  v[0] = a.x; v[1] = a.y; v[2] = a.z; v[3] = a.w; v[4] = b.x; v[5] = b.y; v[6] = b.z; v[7] = b.w;
}

__device__ __forceinline__ void transpose_tile(const float* __restrict__ src, int K, int N, bf16_t* __restrict__ dst, int kt, int nt, bool perm, float* sm) {
  const int tid = otid();
  const int k0 = kt * 64, n0 = nt * 64;
  float tv[16];
#pragma unroll
  for (int i = 0; i < 16; ++i) {
    int k = i * 4 + (tid >> 6), n = tid & 63;
    tv[i] = (n0 + n < N) ? src[(size_t)(k0 + k) * N + n0 + n] : 0.f;
  }
#pragma unroll
  for (int i = 0; i < 16; ++i) {
    int k = i * 4 + (tid >> 6), n = tid & 63;
    sm[k * 65 + n] = tv[i];
  }
  __syncthreads();
  {
    int n = tid >> 2, kq = (tid & 3) * 16;
    int ng = n0 + n;
    if (ng < N) {
      int dn = ng;
      if (perm) dn = ng < 1280 ? ng : (ng < 1304 ? 4864 + (ng - 1280) : ng - 24);
      uint32_t w[8];
#pragma unroll
      for (int i = 0; i < 8; ++i) w[i] = pack2(sm[(kq + 2 * i) * 65 + n], sm[(kq + 2 * i + 1) * 65 + n]);
      uint4* d = (uint4*)(dst + (size_t)dn * K + k0 + kq);
      d[0] = make_uint4(w[0], w[1], w[2], w[3]);
      d[1] = make_uint4(w[4], w[5], w[6], w[7]);
    }
  }
  __syncthreads();
}

__device__ __forceinline__ void s5_table_unit(const Params& p, int g, int tg, char* smem) {
  float2* ap = (float2*)smem;
  float2* zz = ap + 5 * 64;
  float2* bb = zz + 64;
  float* cR = (float*)(bb + 1024);
  float* cI = cR + 16 * 65;
  const int tid = otid();
#pragma unroll
  for (int i = 0; i < 4; ++i) {
    int idx = tid + i * 256;
    cR[(idx >> 6) * 65 + (idx & 63)] = p.c_re[(size_t)g * 1024 + idx];
    cI[(idx >> 6) * 65 + (idx & 63)] = p.c_im[(size_t)g * 1024 + idx];
  }
  const double dt = exp((double)p.log_dt[g]);
  if (tid < 64) {
    int pidx = g * 64 + tid;
    double lr = (double)p.lam_re[pidx], li = (double)p.lam_im[pidx];
    double mag = exp(lr * dt), s1, c1;
    sincos_d(li * dt, s1, c1);
    double ar = mag * c1, ai = mag * s1;
    double den = lr * lr + li * li;
    double zr = ((ar - 1.0) * lr + ai * li) / den;
    double zi = (ai * lr - (ar - 1.0) * li) / den;
    zz[tid] = make_float2((float)zr, (float)zi);
  }
  for (int e = tid; e < 320; e += 256) {
    const int tj = e >> 6, pp = e & 63, tau = tg * 5 + tj;
    if (tau <= 64) {
      const int pidx = g * 64 + pp;
      const double lr = (double)p.lam_re[pidx], li = (double)p.lam_im[pidx];
      double mt = exp(lr * dt * (double)tau), st, ct;
      sincos_d(li * dt * (double)tau, st, ct);
      const float2 a = make_float2((float)(mt * ct), (float)(mt * st));
      ap[tj * 64 + pp] = a;
      if (tau == 64) ((float2*)(p.ws + OFF_AL))[pidx] = a;
    }
  }
  __syncthreads();
#pragma unroll
  for (int i = 0; i < 4; ++i) {
    int idx = tid + i * 256; int pp = idx >> 4, ci = idx & 15;
    float br = p.b_re[(size_t)(g * 64 + pp) * 16 + ci], bi = p.b_im[(size_t)(g * 64 + pp) * 16 + ci];
    float2 z = zz[pp];
    bb[idx] = make_float2(z.x * br - z.y * bi, z.x * bi + z.y * br);
  }
  __syncthreads();
#pragma unroll 1
  for (int tj = 0; tj < 5; ++tj) {
    const int tau = tg * 5 + tj;
    if (tau > 64) break;
    const float2* apt = ap + tj * 64;
    if (tau < 64) {
      {
        int co = tid >> 4, ci = tid & 15;
        float acc = 0.f;
#pragma unroll 8
        for (int pp = 0; pp < 64; ++pp) {
          float cr = cR[co * 65 + pp], cim = cI[co * 65 + pp];
          float2 a = apt[pp], b2 = bb[pp * 16 + ci];
          float wr_ = a.x * b2.x - a.y * b2.y, wi_ = a.x * b2.y + a.y * b2.x;
          acc += cr * wr_ - cim * wi_;
        }
        ((bf16_t*)(p.ws + OFF_KT))[((size_t)(g * 64 + tau) * 16 + co) * 16 + ci] = f2bf(acc);
      }
      {
        int j = 63 - tau;
        bf16_t* W = (bf16_t*)(p.ws + OFF_WIN5) + (size_t)g * 128 * 1024;
#pragma unroll
        for (int i = 0; i < 8; ++i) {
          int idx = tid + i * 256; int n = idx >> 4, ci = idx & 15; int pp = n & 63;
          float2 a = apt[pp], b2 = bb[pp * 16 + ci];
          float v = (n < 64) ? (a.x * b2.x - a.y * b2.y) : (a.x * b2.y + a.y * b2.x);
          W[(size_t)n * 1024 + j * 16 + ci] = f2bf(v);
        }
      }
    }
    if (tau >= 1) {
      int i_ = tau - 1;
      bf16_t* W = (bf16_t*)(p.ws + OFF_WOUT5) + (size_t)g * 1024 * 128;
#pragma unroll
      for (int i = 0; i < 8; ++i) {
        int idx = tid + i * 256; int co = idx >> 7, k = idx & 127; int pp = k & 63;
        float cr = cR[co * 65 + pp], cim = cI[co * 65 + pp];
        float2 a = apt[pp];
        float er = cr * a.x - cim * a.y, ei = cr * a.y + cim * a.x;
        W[(size_t)(i_ * 16 + co) * 128 + k] = f2bf(k < 64 ? er : -ei);
      }
    }
  }
  __syncthreads();
}

__shared__ int q0_s;
__device__ __forceinline__ void phase0(const Params& p, char* smem) {
  const int tid = otid(), lane = tid & 63, wid = tid >> 6;
  constexpr int U_HN = 1024;
  constexpr int U_WIN = 16 * 77;
  constexpr int U_W1 = 32 * 4;
  constexpr int U_W2 = 4;
  constexpr int U_GLU = 64, U_PA = 8 * 16, U_PB = 8 * 16, U_OUT = 256;
  constexpr int U_BIAS = 128, U_ROPE = 512, U_S5 = 32 * 13;
  constexpr int B0 = 0, B1 = B0 + U_S5, B2 = B1 + U_BIAS, B3 = B2 + U_WIN, B4 = B3 + 2 * U_W1, B5 = B4 + 2 * U_W2, B6 = B5 + U_GLU,
                B7 = B6 + U_PA, B8 = B7 + U_PB, B9 = B8 + U_OUT, B10 = B9 + U_ROPE, B11 = B10 + U_HN;
  constexpr int NTK = B11 - (B9 - B5);
#if MULTI_LAUNCH
  for (int qk = blockIdx.x; qk < NTK; qk += gridDim.x) {
#else
  unsigned* qctr = (unsigned*)(p.ws + OFF_BAR) + 3456 + 1024;
  int ks = blockIdx.x; bool dyn = false;
  for (;;) {
    int qk;
    if (!dyn) {
      qk = U_S5 + U_HN + ks; ks += gridDim.x;
      if (qk >= NTK) { dyn = true; continue; }
    } else {
      __syncthreads();
      if (tid == 0) q0_s = (int)__hip_atomic_fetch_add(qctr, 1u, __ATOMIC_RELAXED, __HIP_MEMORY_SCOPE_AGENT);
      __syncthreads();
      qk = q0_s;
      if (qk >= U_S5 + U_HN) break;
    }
#endif
    int u0;
    if (qk < U_S5) u0 = qk;
    else if (qk < U_S5 + U_HN) u0 = (B5 + U_ROPE) + (qk - U_S5);
    else u0 = B1 + (qk - U_S5 - U_HN);
    const int u = u0 < B5 ? u0 : u0 + (B9 - B5);
    if (u < B1) {
      s5_table_unit(p, u / 13, u % 13, smem);
    } else if (u < B2) {
      int v = u - B1; int kv = v >> 6, sl = v & 63;
      const float* w1 = kv ? p.w1v : p.w1k; const float* pos = kv ? p.pos_v : p.pos_k;
      float acc = 0.f;
#pragma unroll
      for (int k = 0; k < 32; ++k) acc += pos[sl * 32 + k] * w1[(size_t)(sl * 32 + k) * 256 + tid];
      ((float*)(p.ws + OFF_BP))[(kv * 64 + sl) * 256 + tid] = acc;
    } else if (u < B3) {
      int v = u - B2; transpose_tile(p.w_in, 1024, 4888, (bf16_t*)(p.ws + OFF_WINT), v / 77, v % 77, true, (float*)smem);
    } else if (u < B4) {
      int v = u - B3; int kv = v / U_W1; v %= U_W1;
      transpose_tile(kv ? p.w1v : p.w1k, 2048, 256, (bf16_t*)(p.ws + (kv ? OFF_W1VT : OFF_W1KT)), v >> 2, v & 3, false, (float*)smem);
    } else if (u < B5) {
      int v = u - B4; int kv = v / U_W2; v %= U_W2;
      transpose_tile(kv ? p.w2v : p.w2k, 256, 64, (bf16_t*)(p.ws + (kv ? OFF_W2VT : OFF_W2KT)), v, 0, false, (float*)smem);
    } else if (u < B10) {
      int idx = (u - B9) * 256 + tid;
      int pos = idx >> 5, j = idx & 31;
      float invf = (float)exp(-(double)j * (9.210340371976184 / 32.0));
      float ang = (float)pos * invf;
      double s, c; sincos_d((double)ang, s, c);
      ((float2*)(p.ws + OFF_ROPE))[idx] = make_float2((float)c, (float)s);
    } else {
      const int row0 = (u - B10) * 16 + wid * 4;
      float4 v[4][4]; float ss[4];
#pragma unroll
      for (int r = 0; r < 4; ++r) {
        const float4* xr = (const float4*)(p.x + (size_t)(row0 + r) * DM);
#pragma unroll
        for (int i = 0; i < 4; ++i) v[r][i] = xr[lane + i * 64];
      }
      float4 g[4];
#pragma unroll
      for (int i = 0; i < 4; ++i) g[i] = ((const float4*)p.norm_g)[lane + i * 64];
#pragma unroll
      for (int r = 0; r < 4; ++r) {
        ss[r] = 0.f;
#pragma unroll
        for (int i = 0; i < 4; ++i) ss[r] += v[r][i].x * v[r][i].x + v[r][i].y * v[r][i].y + v[r][i].z * v[r][i].z + v[r][i].w * v[r][i].w;
      }
#pragma unroll
      for (int o = 32; o >= 1; o >>= 1) {
#pragma unroll
        for (int r = 0; r < 4; ++r) ss[r] += __shfl_xor(ss[r], o);
      }
#pragma unroll
      for (int r = 0; r < 4; ++r) {
        const float rs = rsqrtf(ss[r] * (1.0f / DM) + 1.0e-6f);
        bf16_t* hn = (bf16_t*)(p.ws + OFF_HN) + (size_t)(row0 + r) * DM;
#pragma unroll
        for (int i = 0; i < 4; ++i) {
          uint2 w; w.x = cvt_pk_bf16(v[r][i].x * rs * g[i].x, v[r][i].y * rs * g[i].y); w.y = cvt_pk_bf16(v[r][i].z * rs * g[i].z, v[r][i].w * rs * g[i].w);
          *(uint2*)(hn + (lane + i * 64) * 4) = w;
        }
      }
    }
  }
}

__shared__ int xinfo_s[4];
__device__ __forceinline__ bool xcd_tile(int i, int nct, int& rt, int& ct) {
#if MULTI_LAUNCH
  const int G = gridDim.x;
  int t = blockIdx.x + i * G; if (t >= 128 * nct) return false; rt = t / nct; ct = t % nct; return true;
#else
  const int xi = xinfo_s[0], nx = xinfo_s[1], rank = xinfo_s[2], nloc = xinfo_s[3];
  const int r_lo = (xi * 128) / nx, r_hi = ((xi + 1) * 128) / nx, nrt = r_hi - r_lo;
  const int L = i * nloc + rank; if (L >= nrt * nct) return false;
  ct = L / nrt; rt = r_lo + (L - ct * nrt); return true;
#endif
}

constexpr float QSCALE = 0.125f * 1.4426950408889634f;

__device__ __forceinline__ void proj_epilogue(const Params& p, AccT& acc, int m0, int ct, float* Tl, int wr, int wc, int lane, int tid) {
  const int b = m0 >> 12, tb = m0 & 4095;
  char* oo = (char*)p.out;
  if (ct == 7 || ct == 9) acc_to_lds<true>(acc, Tl, wr, wc, lane); else acc_to_lds<false>(acc, Tl, wr, wc, lane);
  __syncthreads();
  if (ct < 4 || ct == 6 || ct == 8) {
    const float2* rope = (const float2*)(p.ws + OFF_ROPE);
#pragma unroll 2
    for (int i = 0; i < 4; ++i) {
      const int id = tid + i * 256; const int j = id & 3, hh = (id >> 2) & 1, row = id >> 3;
      const int tl = tb + row;
      const float4* rp = (const float4*)(rope + tl * 32 + j * 8);
      const float4 r0 = rp[0], r1 = rp[1], r2 = rp[2], r3 = rp[3];
      float a[8], bq[8];
      lds_chunk8(Tl, row, hh * 8 + j, a); lds_chunk8(Tl, row, hh * 8 + 4 + j, bq);
      const float cs[8] = {r0.x, r0.z, r1.x, r1.z, r2.x, r2.z, r3.x, r3.z};
      const float sn[8] = {r0.y, r0.w, r1.y, r1.w, r2.y, r2.w, r3.y, r3.w};
      float ra[8], rb[8];
#pragma unroll
      for (int k = 0; k < 8; ++k) { ra[k] = a[k] * cs[k] - bq[k] * sn[k]; rb[k] = bq[k] * cs[k] + a[k] * sn[k]; }
      if (ct < 4) {
        const int hd = ct * 2 + hh;
        const size_t o = ((size_t)(b * T_ + tl)) * 512 + hd * 64 + j * 8;
#pragma unroll
        for (int k = 0; k < 8; ++k) { a[k] *= QSCALE; bq[k] *= QSCALE; ra[k] *= QSCALE; rb[k] *= QSCALE; }
        bf16_t* Q = (bf16_t*)(oo + OO_Q); bf16_t* QR = (bf16_t*)(oo + OO_QR);
        *(uint4*)(Q + o) = pack8(a); *(uint4*)(Q + o + 32) = pack8(bq);
        *(uint4*)(QR + o) = pack8(ra); *(uint4*)(QR + o + 32) = pack8(rb);
      } else {
        bf16_t* Kd = (bf16_t*)(oo + (ct == 6 ? OO_KS : OO_KW));
        const size_t o = ((size_t)((b * 2 + hh) * T_ + tl)) * 64 + j * 8;
        *(uint4*)(Kd + o) = pack8(ra); *(uint4*)(Kd + o + 32) = pack8(rb);
      }
    }
  } else {
#pragma unroll 2
    for (int i = 0; i < 8; ++i) {
      const int id = tid + i * 256; const int row = id >> 4, c8 = id & 15;
      float v[8]; lds_chunk8(Tl, row, c8, v);
      const size_t tok = (size_t)b * T_ + tb + row;
      if (ct == 4 || ct == 5) {
        bf16_t* Kd = (bf16_t*)(oo + (ct == 4 ? OO_KC : OO_VC));
        *(uint4*)(Kd + ((size_t)((b * 2 + (c8 >> 3)) * T_ + tb + row)) * 64 + (c8 & 7) * 8) = pack8(v);
      } else if (ct == 7 || ct == 9) {
        bf16_t* Vd = (bf16_t*)(oo + (ct == 7 ? OO_VST : OO_VWT));
        *(uint4*)(Vd + ((size_t)((b * 2 + (row >> 6)) * 64 + (row & 63))) * T_ + tb + c8 * 8) = pack8(v);
      } else if (ct < 14) {
#pragma unroll
        for (int k = 0; k < 8; ++k) v[k] = siluf_(v[k]);
        *(uint4*)((bf16_t*)(p.ws + OFF_GN) + tok * 512 + (ct - 10) * 128 + c8 * 8) = pack8(v);
      } else if (ct < 18) {
        const int ch0 = (ct - 14) * 128 + c8 * 8;
        *(uint4*)((bf16_t*)(p.ws + OFF_U2) + ((size_t)(b * 32 + (ch0 >> 4)) * T_ + tb + row) * 16 + (ch0 & 15)) = pack8(v);
      } else if (ct < 22) {
#pragma unroll
        for (int k = 0; k < 8; ++k) v[k] = siluf_(v[k]);
        *(uint4*)((bf16_t*)(p.ws + OFF_GS) + tok * 512 + (ct - 18) * 128 + c8 * 8) = pack8(v);
      } else if (ct < 38) {
#pragma unroll
        for (int k = 0; k < 8; ++k) v[k] = sigmoidf_(v[k]);
        bf16_t* M = (bf16_t*)(p.ws + (ct < 30 ? OFF_MGA : OFF_MGB));
        *(uint4*)(M + tok * 1024 + ((ct - 22) & 7) * 128 + c8 * 8) = pack8(v);
      } else if (c8 < 3) {
#pragma unroll
        for (int k = 0; k < 8; ++k) v[k] = sigmoidf_(v[k]);
        st8f((float*)(p.ws + OFF_GL) + tok * 32 + c8 * 8, v);
      }
    }
  }
  __syncthreads();
}

__device__ __forceinline__ void phase1(const Params& p, char* smem) {
  const int tid_ = otid(); const int lane = tid_ & 63, wid = tid_ >> 6, wr = wid >> 1, wc = wid & 1;
  for (int i = 0;; ++i) {
    int rt, ct; if (!xcd_tile(i, 39, rt, ct)) break;
    AccT acc; zero_acc(acc);
    gemm_mainloop_dma(acc, (const bf16_t*)(p.ws + OFF_HN) + (size_t)rt * 128 * DM, DM, (const bf16_t*)(p.ws + OFF_WINT) + (size_t)ct * 128 * DM, DM, 16, (bf16_t*)smem);
    proj_epilogue(p, acc, rt * 128, ct, (float*)smem, wr, wc, lane, tid_);
  }
}

struct LdCmpA {
  const bf16_t* base; int m0, koff;
  __device__ __forceinline__ uint4 operator()(int row, int it, int q) const {
    int r = m0 + row; int bg = r >> 8, c = r & 255; if (c > 254) c = 254;
    return *(const uint4*)(base + ((size_t)bg * T_ + c * 16) * 64 + koff + it * 64 + q * 8);
  }
};
struct LdS5U {
  const bf16_t* u2; int g, m0, koff;
  __device__ __forceinline__ uint4 operator()(int row, int it, int q) const {
    int r = m0 + row; int b = r >> 6, c = r & 63;
    return *(const uint4*)(u2 + ((size_t)(b * 32 + g) * T_ + c * 64) * 16 + koff + it * 64 + q * 8);
  }
};

__device__ __forceinline__ void phase2(const Params& p, char* smem) {
  const int tid_ = otid(); const int lane = tid_ & 63, wid = tid_ >> 6, wr = wid >> 1, wc = wid & 1, h = lane >> 5, cl = lane & 31;
  for (int t = blockIdx.x; t < 256 + 128 + 2; t += gridDim.x) {
    if (t < 256) {
      AccT acc; zero_acc(acc);
      int kv = t >> 7, sp = (t >> 5) & 3, rt = (t >> 1) & 15, ct = t & 1;
      LdCmpA al{(const bf16_t*)((char*)p.out + (kv ? OO_VC : OO_KC)), rt * 128, sp * 512};
      LdPlain bl{(const bf16_t*)(p.ws + (kv ? OFF_W1VT : OFF_W1KT)) + (size_t)ct * 128 * 2048 + sp * 512, 2048};
      gemm_mainloop(acc, al, bl, 8, (bf16_t*)smem);
      float* HP = (float*)(p.ws + OFF_HP) + (size_t)(kv * 4 + sp) * 2048 * 256;
      float* Tl = (float*)smem;
      acc_to_lds<false>(acc, Tl, wr, wc, lane);
      __syncthreads();
#pragma unroll 2
      for (int i = 0; i < 8; ++i) {
        const int id = tid_ + i * 256; const int row = id >> 4, c8 = id & 15;
        float v[8]; lds_chunk8(Tl, row, c8, v);
        st8f(HP + (size_t)(rt * 128 + row) * 256 + ct * 128 + c8 * 8, v);
      }
      __syncthreads();
    } else if (t < 384) {
      AccT acc; zero_acc(acc);
      int v = t - 256; int g = v >> 2, rt = (v >> 1) & 1, sp = v & 1;
      LdS5U al{(const bf16_t*)(p.ws + OFF_U2), g, rt * 128, sp * 512};
      LdPlain bl{(const bf16_t*)(p.ws + OFF_WIN5) + (size_t)g * 128 * 1024 + sp * 512, 1024};
      gemm_mainloop(acc, al, bl, 8, (bf16_t*)smem);
      float* E = (float*)(p.ws + OFF_E2) + ((size_t)sp * 32 + g) * 256 * 128;
      float* Tl = (float*)smem;
      acc_to_lds<false>(acc, Tl, wr, wc, lane);
      __syncthreads();
#pragma unroll 2
      for (int i = 0; i < 8; ++i) {
        const int id = tid_ + i * 256; const int row = id >> 4, c8 = id & 15;
        float v[8]; lds_chunk8(Tl, row, c8, v);
        st8f(E + (size_t)(rt * 128 + row) * 128 + c8 * 8, v);
      }
      __syncthreads();
    } else {
      int kv = t - 384;
      const float* BP = (const float*)(p.ws + OFF_BP) + kv * 64 * 256;
      float a = 0.f;
#pragma unroll 16
      for (int i = 0; i < 64; ++i) a += BP[i * 256 + tid_];
      ((float*)(p.ws + OFF_BIAS1))[kv * 256 + tid_] = a;
    }
  }
}

struct LdHid {
  const float* hp; const float* bias; int m0;
  __device__ __forceinline__ uint4 operator()(int row, int it, int q) const {
    int n0 = it * 64 + q * 8;
    const float* b0 = hp + (size_t)(m0 + row) * 256 + n0;
    float4 x0 = *(const float4*)(bias + n0), x1 = *(const float4*)(bias + n0 + 4);
#pragma unroll
    for (int sp = 0; sp < 4; ++sp) {
      float4 a = *(const float4*)(b0 + (size_t)sp * 2048 * 256), b = *(const float4*)(b0 + (size_t)sp * 2048 * 256 + 4);
      x0.x += a.x; x0.y += a.y; x0.z += a.z; x0.w += a.w; x1.x += b.x; x1.y += b.y; x1.z += b.z; x1.w += b.w;
    }
    return make_uint4(pack2(geluf_(x0.x), geluf_(x0.y)), pack2(geluf_(x0.z), geluf_(x0.w)), pack2(geluf_(x1.x), geluf_(x1.y)), pack2(geluf_(x1.z), geluf_(x1.w)));
  }
};

__device__ __forceinline__ void phase3(const Params& p, char* smem) {
  const int tid = otid(), lane = tid & 63, wid = tid >> 6, wr = wid >> 1, wc = wid & 1, h = lane >> 5, cl = lane & 31;
  for (int t = blockIdx.x; t < 64 + 576; t += gridDim.x) {
    if (t >= 64) {
      const int v0 = t - 64;
      if (v0 < 64) { transpose_tile(p.w_glu, 512, 512, (bf16_t*)(p.ws + OFF_WGLUT), v0 >> 3, v0 & 7, false, (float*)smem); }
      else if (v0 < 192) { const int v = v0 - 64; transpose_tile(p.w_pa, 512, 1024, (bf16_t*)(p.ws + OFF_WAT), v >> 4, v & 15, false, (float*)smem); }
      else if (v0 < 320) { const int v = v0 - 192; transpose_tile(p.w_pb, 512, 1024, (bf16_t*)(p.ws + OFF_WBT), v >> 4, v & 15, false, (float*)smem); }
      else { const int v = v0 - 320; transpose_tile(p.w_out, 1024, 1024, (bf16_t*)(p.ws + OFF_WOUTT), v >> 4, v & 15, false, (float*)smem); }
    } else if (t < 32) {
      int kv = t >> 4, rt = t & 15;
      AccT acc; zero_acc(acc);
      LdHid al{(const float*)(p.ws + OFF_HP) + (size_t)kv * 4 * 2048 * 256, (const float*)(p.ws + OFF_BIAS1) + kv * 256, rt * 128};
      LdPlain bl{(const bf16_t*)(p.ws + (kv ? OFF_W2VT : OFF_W2KT)), 256};
      gemm_mainloop(acc, al, bl, 4, (bf16_t*)smem);
      float* Tl = (float*)smem;
      if (kv == 0) {
        acc_to_lds<false>(acc, Tl, wr, wc, lane);
        __syncthreads();
        bf16_t* KC = (bf16_t*)(p.ws + OFF_KCMP);
#pragma unroll 2
        for (int i = 0; i < 4; ++i) {
          const int id = tid + i * 256; const int row = id >> 3, c8 = id & 7;
          float v[8]; lds_chunk8(Tl, row, c8, v);
          const int grow = rt * 128 + row;
          if ((grow & 255) == 255) {
#pragma unroll
            for (int k = 0; k < 8; ++k) v[k] = 0.f;
          }
          *(uint4*)(KC + (size_t)grow * 64 + c8 * 8) = pack8(v);
        }
      } else {
        acc_to_lds<true>(acc, Tl, wr, wc, lane);
        __syncthreads();
        bf16_t* VT = (bf16_t*)(p.ws + OFF_VCMPT);
#pragma unroll 2
        for (int i = 0; i < 4; ++i) {
          const int id = tid + i * 256; const int d = id >> 4, c8 = id & 15;
          float v[8]; lds_chunk8(Tl, d, c8, v);
          const int grow = rt * 128 + c8 * 8; const int bg = grow >> 8, c0 = grow & 255;
          if (c0 == 248) v[7] = 0.f;
          *(uint4*)(VT + ((size_t)bg * 64 + d) * 256 + c0) = pack8(v);
        }
      }
      __syncthreads();
    } else {
      int idx = (t - 32) * 256 + tid;
      int pp = idx & 63, g = (idx >> 6) & 31, b = idx >> 11;
      float2 a = ((const float2*)(p.ws + OFF_AL))[g * 64 + pp];
      const float* E0 = (const float*)(p.ws + OFF_E2) + ((size_t)g * 256 + b * 64) * 128;
      const float* E1 = E0 + (size_t)32 * 256 * 128;
      bf16_t* S = (bf16_t*)(p.ws + OFF_SPREV) + ((size_t)g * 256 + b * 64) * 128;
      float sr = 0.f, si = 0.f;
#pragma unroll 1
      for (int cb = 0; cb < 64; cb += 16) {
        float er[16], ei[16];
#pragma unroll
        for (int c = 0; c < 16; ++c) {
          er[c] = E0[(cb + c) * 128 + pp] + E1[(cb + c) * 128 + pp];
          ei[c] = E0[(cb + c) * 128 + 64 + pp] + E1[(cb + c) * 128 + 64 + pp];
        }
#pragma unroll
        for (int c = 0; c < 16; ++c) {
          S[(cb + c) * 128 + pp] = f2bf(sr); S[(cb + c) * 128 + 64 + pp] = f2bf(si);
          float nr = a.x * sr - a.y * si + er[c], ni_ = a.x * si + a.y * sr + ei[c];
          sr = nr; si = ni_;
        }
      }
    }
  }
}

constexpr int KS_STRIDE = 72, VS_STRIDE = 68;
constexpr int KS_ELEMS = 64 * KS_STRIDE, VS_ELEMS = 64 * VS_STRIDE;
constexpr int NSA_KV_BYTES = 2 * (KS_ELEMS + VS_ELEMS) * 2;
constexpr int NSA_SMEM_BYTES = NSA_KV_BYTES + 4 * 32 * 65 * 4 + 32 * 65 * 4 + 256;


#define TRD uint4 &tk0, uint4 &tk1, uint4 &tv0, uint4 &tv1
#define TRA tk0, tk1, tv0, tv1
__device__ __forceinline__ void tile_gload(TRD, const bf16_t* kbase, const bf16_t* vbase, size_t vstride, int n, int tid) {
  const int r = tid >> 3, q = tid & 7;
  tk0 = *(const uint4*)(kbase + (size_t)(n * 64 + r) * 64 + q * 8);
  tk1 = *(const uint4*)(kbase + (size_t)(n * 64 + r + 32) * 64 + q * 8);
  tv0 = *(const uint4*)(vbase + (size_t)r * vstride + n * 64 + q * 8);
  tv1 = *(const uint4*)(vbase + (size_t)(r + 32) * vstride + n * 64 + q * 8);
}
__device__ __forceinline__ void tile_sstore(TRD, bf16_t* Ks, bf16_t* Vs, int tid) {
  const int r = tid >> 3, q = tid & 7;
  *(uint4*)(Ks + r * KS_STRIDE + q * 8) = tk0;
  *(uint4*)(Ks + (r + 32) * KS_STRIDE + q * 8) = tk1;
  *(uint2*)(Vs + r * VS_STRIDE + q * 8) = make_uint2(tv0.x, tv0.y);
  *(uint2*)(Vs + r * VS_STRIDE + q * 8 + 4) = make_uint2(tv0.z, tv0.w);
  *(uint2*)(Vs + (r + 32) * VS_STRIDE + q * 8) = make_uint2(tv1.x, tv1.y);
  *(uint2*)(Vs + (r + 32) * VS_STRIDE + q * 8 + 4) = make_uint2(tv1.z, tv1.w);
}

__device__ __forceinline__ float xhalf_max(float v) {
  auto r = __builtin_amdgcn_permlane32_swap(__float_as_uint(v), __float_as_uint(v), false, false);
  return fmaxf(__uint_as_float(r[0]), __uint_as_float(r[1]));
}
__device__ __forceinline__ float xhalf_other(float v, int h) {
  auto r = __builtin_amdgcn_permlane32_swap(__float_as_uint(v), __float_as_uint(v), false, false);
  return __uint_as_float(h ? r[0] : r[1]);
}
__device__ __forceinline__ float xhalf_sum(float v) {
  auto r = __builtin_amdgcn_permlane32_swap(__float_as_uint(v), __float_as_uint(v), false, false);
  return __uint_as_float(r[0]) + __uint_as_float(r[1]);
}
__device__ __forceinline__ void qk_tile(const bf16_t* Ks, const bf16x8 (&Qf)[4], f32x16 (&S)[2], int cl, int h) {
#pragma unroll
  for (int kt = 0; kt < 2; ++kt) {
    if (kt) asm volatile("" ::: "memory");
#pragma unroll
    for (int r = 0; r < 16; ++r) S[kt][r] = 0.f;
#pragma unroll
    for (int kk = 0; kk < 4; ++kk) {
      bf16x8 kf = *(const bf16x8*)(Ks + (kt * 32 + cl) * KS_STRIDE + kk * 16 + h * 8);
      S[kt] = __builtin_amdgcn_mfma_f32_32x32x16_bf16(kf, Qf[kk], S[kt], 0, 0, 0);
    }
  }
}
__device__ __forceinline__ void pv_tile(const bf16_t* Vs, const f32x16 (&S)[2], f32x16 (&O)[2], int cl, int h) {
#pragma unroll
  for (int kt = 0; kt < 2; ++kt)
#pragma unroll
    for (int s2 = 0; s2 < 2; ++s2) {
      if (kt | s2) asm volatile("" ::: "memory");
      u32x4 pu;
      pu.x = cvt_pk_bf16(S[kt][8 * s2 + 0], S[kt][8 * s2 + 1]); pu.y = cvt_pk_bf16(S[kt][8 * s2 + 2], S[kt][8 * s2 + 3]);
      pu.z = cvt_pk_bf16(S[kt][8 * s2 + 4], S[kt][8 * s2 + 5]); pu.w = cvt_pk_bf16(S[kt][8 * s2 + 6], S[kt][8 * s2 + 7]);
      const bf16x8 pfv = __builtin_bit_cast(bf16x8, pu);
#pragma unroll
      for (int dt = 0; dt < 2; ++dt) {
        const bf16_t* vp = Vs + (dt * 32 + cl) * VS_STRIDE + kt * 32 + s2 * 16 + 4 * h;
        const uint2 va0 = *(const uint2*)(vp), va1 = *(const uint2*)(vp + 8);
        u32x4 vu; vu.x = va0.x; vu.y = va0.y; vu.z = va1.x; vu.w = va1.y;
        O[dt] = __builtin_amdgcn_mfma_f32_32x32x16_bf16(__builtin_bit_cast(bf16x8, vu), pfv, O[dt], 0, 0, 0);
      }
    }
}

template <class VF>
__device__ __forceinline__ void attn_tile64(const bf16_t* Ks, const bf16_t* Vs, const bf16x8 (&Qf)[4], f32x16 (&O)[2], float& m, float& l, bool bit, bool mask_on,
                                            const VF& valid, int cl, int h) {
  f32x16 S[2];
  qk_tile(Ks, Qf, S, cl, h);
  if (mask_on) {
#pragma unroll
    for (int kt = 0; kt < 2; ++kt)
#pragma unroll
      for (int r = 0; r < 16; ++r) S[kt][r] = valid(kt, r) ? S[kt][r] : -1.0e30f;
  }
  float mx = -1.0e30f;
#pragma unroll
  for (int kt = 0; kt < 2; ++kt)
#pragma unroll
    for (int r = 0; r < 16; ++r) mx = fmaxf(mx, S[kt][r]);
  mx = xhalf_max(mx);
  if (__ballot(bit && (mx > m + 8.0f)) != 0ull) {
    const float mnew = bit ? fmaxf(m, mx) : m;
    const float alpha = ex2(m - mnew);
    l *= alpha;
#pragma unroll
    for (int dt = 0; dt < 2; ++dt)
#pragma unroll
      for (int r = 0; r < 16; ++r) O[dt][r] *= alpha;
    m = mnew;
  }
  const float meff = bit ? m : 1.0e30f;
  float ps = 0.f;
#pragma unroll
  for (int kt = 0; kt < 2; ++kt)
#pragma unroll
    for (int r = 0; r < 16; ++r) {
      float pv = ex2(S[kt][r] - meff);
      S[kt][r] = pv; ps += pv;
    }
  l += ps;
  pv_tile(Vs, S, O, cl, h);
}

__device__ __forceinline__ void nsa_unit(const Params& p, int b, int g, int qt, char* smem) {
  const int tid = otid(), lane = tid & 63, w = tid >> 6, h = lane >> 5, cl = lane & 31;
  bf16_t* KsB = (bf16_t*)smem;
  bf16_t* VsB = KsB + 2 * KS_ELEMS;
  float* impS = (float*)(smem + NSA_KV_BYTES);
  float* valS = impS + 4 * 32 * 65;
  unsigned char* maskS = (unsigned char*)(valS + 32 * 65);
  const int hd = g * 4 + w, bg = b * 2 + g;
  const int t0 = qt * 32, tq = t0 + cl;
  const char* oo = (const char*)p.out;
  const size_t qoff = ((size_t)(b * T_ + tq)) * 512 + hd * 64 + h * 8;
  bf16x8 Qf[4];
#pragma unroll
  for (int kk = 0; kk < 4; ++kk) Qf[kk] = *(const bf16x8*)((const bf16_t*)(oo + OO_Q) + qoff + kk * 16);
  f32x16 Of[2];
#define GLV(k) (((const float*)(p.ws + OFF_GL))[((size_t)(b * T_ + tq)) * 32 + hd * 3 + (k)])
  uint4 tk0, tk1, tv0, tv1;
  {
    const int nct = ((2 * qt) >> 6) + 1;
    const bf16_t* KC = (const bf16_t*)(p.ws + OFF_KCMP) + (size_t)bg * 256 * 64;
    const bf16_t* VCT = (const bf16_t*)(p.ws + OFF_VCMPT) + (size_t)bg * 64 * 256;
    float mc = -1.0e30f, lc = 0.f;
    tile_gload(TRA, KC, VCT, 256, 0, tid);
    tile_sstore(TRA, KsB, VsB, tid);
    __syncthreads();
#pragma unroll 1
    for (int pass = 0; pass < 2; ++pass) {
      float inv = 0.f;
      if (pass == 1) {
        float lt = xhalf_sum(lc);
        inv = lt > 0.f ? 1.0f / lt : 0.f;
#pragma unroll
        for (int dt = 0; dt < 2; ++dt)
#pragma unroll
          for (int r = 0; r < 16; ++r) Of[dt][r] = 0.f;
      }
      float carryE = 0.f;
#pragma unroll 1
      for (int n = 0; n < nct; ++n) {
        const int it = pass * nct + n;
        const int buf = it & 1;
        const bool more = it + 1 < 2 * nct;
        if (more) tile_gload(TRA, KC, VCT, 256, (n + 1 < nct) ? n + 1 : 0, tid);
        const bf16_t* Ks = KsB + buf * KS_ELEMS; const bf16_t* Vs = VsB + buf * VS_ELEMS;
        f32x16 S[2];
        qk_tile(Ks, Qf, S, cl, h);
        const bool edge = (n * 64 + 63 >= 2 * qt - 1);
        if (pass == 0) {
          float mx = -1.0e30f;
          if (edge) {
#pragma unroll
            for (int kt = 0; kt < 2; ++kt)
#pragma unroll
              for (int r = 0; r < 16; ++r) {
                int c = n * 64 + kt * 32 + (r & 3) + 8 * (r >> 2) + 4 * h;
                S[kt][r] = (c * 16 + 31 <= tq) ? S[kt][r] : -1.0e30f;
              }
          }
#pragma unroll
          for (int kt = 0; kt < 2; ++kt)
#pragma unroll
            for (int r = 0; r < 16; ++r) mx = fmaxf(mx, S[kt][r]);
          mx = xhalf_max(mx);
          const float mn = fmaxf(mc, mx);
          lc *= ex2(mc - mn);
          mc = mn;
          float ps = 0.f;
          if (edge) {
#pragma unroll
            for (int kt = 0; kt < 2; ++kt)
#pragma unroll
              for (int r = 0; r < 16; ++r) {
                int c = n * 64 + kt * 32 + (r & 3) + 8 * (r >> 2) + 4 * h;
                ps += (c * 16 + 31 <= tq) ? ex2(S[kt][r] - mn) : 0.f;
              }
          } else {
#pragma unroll
            for (int kt = 0; kt < 2; ++kt)
#pragma unroll
              for (int r = 0; r < 16; ++r) ps += ex2(S[kt][r] - mn);
          }
          lc += ps;
        } else {
#pragma unroll
          for (int kt = 0; kt < 2; ++kt) {
            if (edge) {
#pragma unroll
              for (int r = 0; r < 16; ++r) {
                int c = n * 64 + kt * 32 + (r & 3) + 8 * (r >> 2) + 4 * h;
                S[kt][r] = (c * 16 + 31 <= tq) ? ex2(S[kt][r] - mc) * inv : 0.f;
              }
            } else {
#pragma unroll
              for (int r = 0; r < 16; ++r) S[kt][r] = ex2(S[kt][r] - mc) * inv;
            }
#pragma unroll
            for (int q4 = 0; q4 < 4; ++q4) {
              float G = (S[kt][4 * q4] + S[kt][4 * q4 + 1]) + (S[kt][4 * q4 + 2] + S[kt][4 * q4 + 3]);
              float pE = xhalf_other(S[kt][4 * q4 + 3], h);
              float add = h ? pE : carryE;
              carryE = pE;
              impS[(w * 32 + cl) * 65 + n * 16 + kt * 8 + 2 * q4 + h] = G + add;
            }
          }
          pv_tile(Vs, S, Of, cl, h);
        }
        if (more) tile_sstore(TRA, KsB + (buf ^ 1) * KS_ELEMS, VsB + (buf ^ 1) * VS_ELEMS, tid);
        __syncthreads();
      }
    }
    for (int n2 = nct * 16 + h; n2 < 64; n2 += 2) impS[(w * 32 + cl) * 65 + n2] = 0.f;
  }
  __syncthreads();
  {
    int q = tid & 31, part = tid >> 5;
    int tqq = t0 + q, cur = tqq >> 6;
#pragma unroll
    for (int i = 0; i < 8; ++i) {
      int n = part * 8 + i;
      float v = (impS[(0 * 32 + q) * 65 + n] + impS[(1 * 32 + q) * 65 + n]) + (impS[(2 * 32 + q) * 65 + n] + impS[(3 * 32 + q) * 65 + n]);
      bool forced = (n == 0) | (n == cur) | (n == cur - 1);
      v = forced ? 1.0e4f : (n <= cur ? v : -1.0f);
      valS[q * 65 + n] = v;
    }
  }
  __syncthreads();
  {
    const int q = tid & 31, part = tid >> 5;
    float mv[8]; int cnt[8];
#pragma unroll
    for (int i = 0; i < 8; ++i) { mv[i] = valS[q * 65 + part * 8 + i]; cnt[i] = 0; }
#pragma unroll 4
    for (int n2 = 0; n2 < 64; ++n2) {
      const float v2 = valS[q * 65 + n2];
#pragma unroll
      for (int i = 0; i < 8; ++i) cnt[i] += (v2 > mv[i] || (v2 == mv[i] && n2 < part * 8 + i)) ? 1 : 0;
    }
    unsigned bits = 0;
#pragma unroll
    for (int i = 0; i < 8; ++i) bits |= (cnt[i] < 16 ? 1u : 0u) << i;
    maskS[q * 8 + part] = (unsigned char)bits;
  }
  __syncthreads();
  const unsigned long long selmask = *(const unsigned long long*)(maskS + cl * 8);
  unsigned long long umask = selmask;
#pragma unroll
  for (int o = 16; o >= 1; o >>= 1) {
    unsigned lo = __shfl_xor((unsigned)umask, o), hi = __shfl_xor((unsigned)(umask >> 32), o);
    umask |= ((unsigned long long)hi << 32) | lo;
  }
  umask = ((unsigned long long)__builtin_amdgcn_readfirstlane((unsigned)(umask >> 32)) << 32) | (unsigned)__builtin_amdgcn_readfirstlane((unsigned)umask);
  const int cur = t0 >> 6;
  float* stash = impS;
  {
    const float g0 = GLV(0);
#pragma unroll
    for (int dt = 0; dt < 2; ++dt)
#pragma unroll
      for (int r = 0; r < 16; ++r) stash[(dt * 16 + r) * 256 + tid] = Of[dt][r] * g0;
  }
#pragma unroll
  for (int kk = 0; kk < 4; ++kk) Qf[kk] = *(const bf16x8*)((const bf16_t*)(oo + OO_QR) + qoff + kk * 16);
  {
    f32x16 O[2];
    float ms, ls;
    int sel_reps = 1 + (PROBE_DUP == 10 ? 1 : 0); asm volatile("" : "+s"(sel_reps));
#pragma unroll 1
    for (int rep = 0; rep < sel_reps; ++rep) {
#pragma unroll
    for (int dt = 0; dt < 2; ++dt)
#pragma unroll
      for (int r = 0; r < 16; ++r) O[dt][r] = 0.f;
    ms = -1.0e30f; ls = 0.f;
    const bf16_t* KS = (const bf16_t*)(oo + OO_KS) + (size_t)bg * T_ * 64;
    const bf16_t* VST = (const bf16_t*)(oo + OO_VST) + (size_t)bg * 64 * T_;
    unsigned long long rem = (cur > 0) ? (umask & ((1ull << cur) - 1ull)) : 0ull;
    int n = cur, it = 0;
    tile_gload(TRA, KS, VST, T_, n, tid);
    tile_sstore(TRA, KsB, VsB, tid);
    __syncthreads();
#pragma unroll 1
    while (true) {
      const int buf = it & 1;
      int nn = -1;
      if (rem != 0ull) { nn = 63 - __builtin_clzll(rem); rem &= ~(1ull << nn); }
      if (nn >= 0) tile_gload(TRA, KS, VST, T_, nn, tid);
      const bf16_t* Ks = KsB + buf * KS_ELEMS; const bf16_t* Vs = VsB + buf * VS_ELEMS;
      const bool bit = (selmask >> n) & 1ull;
      {
        auto valid = [&](int kt, int r) { int key = n * 64 + kt * 32 + (r & 3) + 8 * (r >> 2) + 4 * h; return key <= tq; };
        attn_tile64(Ks, Vs, Qf, O, ms, ls, bit, n == cur, valid, cl, h);
      }
      if (nn >= 0) tile_sstore(TRA, KsB + (buf ^ 1) * KS_ELEMS, VsB + (buf ^ 1) * VS_ELEMS, tid);
      __syncthreads();
      if (nn < 0) break;
      n = nn; ++it;
    }
    }
    ls = xhalf_sum(ls);
    const float g1 = GLV(1);
    float inv = ls > 0.f ? 1.0f / ls : 0.f;
#pragma unroll
    for (int dt = 0; dt < 2; ++dt)
#pragma unroll
      for (int r = 0; r < 16; ++r) stash[(dt * 16 + r) * 256 + tid] += O[dt][r] * (inv * g1);
  }
  {
    f32x16 O[2];
#pragma unroll
    for (int dt = 0; dt < 2; ++dt)
#pragma unroll
      for (int r = 0; r < 16; ++r) O[dt][r] = 0.f;
    float mw = -1.0e30f, lw = 0.f;
    const bf16_t* KW = (const bf16_t*)(oo + OO_KW) + (size_t)bg * T_ * 64;
    const bf16_t* VWT = (const bf16_t*)(oo + OO_VWT) + (size_t)bg * 64 * T_;
    const int nlo = (t0 - 511) > 0 ? ((t0 - 511) >> 6) : 0;
    int it = 0;
    tile_gload(TRA, KW, VWT, T_, cur, tid);
    tile_sstore(TRA, KsB, VsB, tid);
    __syncthreads();
#pragma unroll 1
    for (int n = cur; n >= nlo; --n, ++it) {
      const int buf = it & 1;
      if (n > nlo) tile_gload(TRA, KW, VWT, T_, n - 1, tid);
      const bf16_t* Ks = KsB + buf * KS_ELEMS; const bf16_t* Vs = VsB + buf * VS_ELEMS;
      const bool edge = (n == cur) || (n * 64 <= t0 + 31 - 512);
      {
        auto valid = [&](int kt, int r) { int key = n * 64 + kt * 32 + (r & 3) + 8 * (r >> 2) + 4 * h; return key <= tq && key > tq - 512; };
        attn_tile64(Ks, Vs, Qf, O, mw, lw, true, edge, valid, cl, h);
      }
      if (n > nlo) tile_sstore(TRA, KsB + (buf ^ 1) * KS_ELEMS, VsB + (buf ^ 1) * VS_ELEMS, tid);
      __syncthreads();
    }
    lw = xhalf_sum(lw);
    const float g2 = GLV(2);
    float inv = lw > 0.f ? 1.0f / lw : 0.f;
#pragma unroll
    for (int dt = 0; dt < 2; ++dt)
#pragma unroll
      for (int r = 0; r < 16; ++r) O[dt][r] = stash[(dt * 16 + r) * 256 + tid] + O[dt][r] * (inv * g2);
  {
    f32x16 (&Of)[2] = O;
    const size_t base = ((size_t)(b * T_ + tq)) * 512 + hd * 64;
    const bf16_t* GN = (const bf16_t*)(p.ws + OFF_GN);
    bf16_t* ON = (bf16_t*)(p.ws + OFF_ONSA);
#pragma unroll
    for (int dt = 0; dt < 2; ++dt)
#pragma unroll
      for (int rq = 0; rq < 4; ++rq) {
        int d = dt * 32 + 8 * rq + 4 * h;
        uint2 gv = *(const uint2*)(GN + base + d);
        float ga = __uint_as_float(gv.x << 16), gb = __uint_as_float(gv.x & 0xffff0000u), gc = __uint_as_float(gv.y << 16), gd = __uint_as_float(gv.y & 0xffff0000u);
        uint2 wv;
        wv.x = pack2(Of[dt][rq * 4 + 0] * ga, Of[dt][rq * 4 + 1] * gb);
        wv.y = pack2(Of[dt][rq * 4 + 2] * gc, Of[dt][rq * 4 + 3] * gd);
        *(uint2*)(ON + base + d) = wv;
      }
  }
  }
}

struct LdS5CA {
  const bf16_t* u2; const bf16_t* sp; int g, m0, nk1;
  __device__ __forceinline__ uint4 operator()(int row, int it, int q) const {
    int r = m0 + row; int b = r >> 6, c = r & 63;
    if (it < nk1) return *(const uint4*)(u2 + ((size_t)(b * 32 + g) * T_ + c * 64) * 16 + it * 64 + q * 8);
    return *(const uint4*)(sp + ((size_t)g * 256 + r) * 128 + (it - nk1) * 64 + q * 8);
  }
};
struct LdS5CB {
  const bf16_t* kt; const bf16_t* wo; int g, n0, nk1;
  __device__ __forceinline__ uint4 operator()(int row, int it, int q) const {
    int n = n0 + row; int i = n >> 4, co = n & 15;
    if (it < nk1) {
      int j = 4 * it + (q >> 1), ci0 = (q & 1) * 8;
      if (i >= j) return *(const uint4*)(kt + (((size_t)(g * 64 + (i - j)) * 16 + co) * 16 + ci0));
      return make_uint4(0, 0, 0, 0);
    }
    return *(const uint4*)(wo + ((size_t)g * 1024 + n) * 128 + (it - nk1) * 64 + q * 8);
  }
};

__device__ __forceinline__ void s5c_tile(const Params& p, int g, int rt, int nt, char* smem) {
  const int tid_ = otid(); const int lane = tid_ & 63, wid = tid_ >> 6, wr = wid >> 1, wc = wid & 1;
  int nk1 = 2 * nt + 2; if (nk1 > 16) nk1 = 16;
  AccT acc; zero_acc(acc);
  LdS5CA al{(const bf16_t*)(p.ws + OFF_U2), (const bf16_t*)(p.ws + OFF_SPREV), g, rt * 128, nk1};
  LdS5CB bl{(const bf16_t*)(p.ws + OFF_KT), (const bf16_t*)(p.ws + OFF_WOUT5), g, nt * 128, nk1};
  gemm_mainloop(acc, al, bl, nk1 + 2, (bf16_t*)smem);
  const bf16_t* U2 = (const bf16_t*)(p.ws + OFF_U2);
  bf16_t* Z = (bf16_t*)(p.ws + OFF_Z);
  float* Tl = (float*)smem;
  acc_to_lds<false>(acc, Tl, wr, wc, lane);
  __syncthreads();
#pragma unroll 1
  for (int i0 = 0; i0 < 8; i0 += 4) {
    uint4 uu[4]; float dd[4][8];
#pragma unroll
    for (int i = 0; i < 4; ++i) {
      const int id = tid_ + (i0 + i) * 256; const int row = id >> 4, c8 = id & 15;
      const int r = rt * 128 + row, n0 = nt * 128 + c8 * 8;
      const int b = r >> 6, c = r & 63, tl = c * 64 + (n0 >> 4), co0 = n0 & 15;
      uu[i] = *(const uint4*)(U2 + ((size_t)(b * 32 + g) * T_ + tl) * 16 + co0);
      ld8f(p.s5d + g * 16 + co0, dd[i]);
    }
#pragma unroll
    for (int i = 0; i < 4; ++i) {
      const int id = tid_ + (i0 + i) * 256; const int row = id >> 4, c8 = id & 15;
      const int r = rt * 128 + row, n0 = nt * 128 + c8 * 8;
      const int b = r >> 6, c = r & 63, tl = c * 64 + (n0 >> 4), co0 = n0 & 15;
      float v[8], u[8]; lds_chunk8(Tl, row, c8, v); unpack8(uu[i], u);
#pragma unroll
      for (int k = 0; k < 8; ++k) v[k] = geluf_(v[k] + dd[i][k] * u[k]);
      *(uint4*)(Z + ((size_t)(b * T_ + tl)) * 512 + g * 16 + co0) = pack8(v);
    }
  }
  __syncthreads();
}

__device__ __forceinline__ void phase4(const Params& p, char* smem) {
  const int n_nsa = 1024, n_s5 = 512;
#if MULTI_LAUNCH
  const int G = gridDim.x, bi = blockIdx.x;
  for (int L = bi; L < n_nsa; L += G) { const int qt = 127 - (L >> 3), bg = L & 7; nsa_unit(p, bg >> 1, bg & 1, qt, smem); }
  for (int v = bi; v < n_s5; v += G) { s5c_tile(p, (v >> 1) & 31, v & 1, 7 - (v >> 6), smem); }
#else
  const int tid = otid();
  const bool xm = (xinfo_s[1] == 8);
  const int xi = xinfo_s[0];
  unsigned* qbase = (unsigned*)(p.ws + OFF_BAR) + 3456 + 1024 + 16;
  unsigned* qa = qbase + 16 * (xm ? xi : 8);
  unsigned* qb = qbase + 16 * (9 + (xm ? xi : 8));
  const int totA = xm ? 128 : n_nsa, totB = xm ? 64 : n_s5;
  for (;;) {
    __syncthreads();
    if (tid == 0) q0_s = (int)__hip_atomic_fetch_add(qa, 1u, __ATOMIC_RELAXED, __HIP_MEMORY_SCOPE_AGENT);
    __syncthreads();
    const int L = q0_s;
    if (L >= totA) break;
    const int qt = xm ? (127 - L) : (127 - (L >> 3)), bg = xm ? xi : (L & 7);
    nsa_unit(p, bg >> 1, bg & 1, qt, smem);
  }
  for (;;) {
    __syncthreads();
    if (tid == 0) q0_s = (int)__hip_atomic_fetch_add(qb, 1u, __ATOMIC_RELAXED, __HIP_MEMORY_SCOPE_AGENT);
    __syncthreads();
    const int v = q0_s;
    if (v >= totB) break;
    const int nt = xm ? (7 - (v >> 3)) : (7 - (v >> 6));
    const int g = xm ? (4 * xi + ((v & 7) >> 1)) : ((v >> 1) & 31);
    s5c_tile(p, g, v & 1, nt, smem);
  }
#endif
}

__device__ __forceinline__ void phase5(const Params& p, char* smem) {
  const int tid_ = otid(); const int lane = tid_ & 63, wid = tid_ >> 6, wr = wid >> 1, wc = wid & 1, h = lane >> 5, cl = lane & 31;
  for (int i = 0;; ++i) {
    int rt, ct; if (!xcd_tile(i, 4, rt, ct)) break;
    AccT acc; zero_acc(acc);
    gemm_mainloop_dma(acc, (const bf16_t*)(p.ws + OFF_Z) + (size_t)rt * 128 * 512, 512, (const bf16_t*)(p.ws + OFF_WGLUT) + (size_t)ct * 128 * 512, 512, 8, (bf16_t*)smem);
    const bf16_t* Z = (const bf16_t*)(p.ws + OFF_Z); const bf16_t* GS = (const bf16_t*)(p.ws + OFF_GS);
    bf16_t* OS = (bf16_t*)(p.ws + OFF_OS5);
    float* Tl = (float*)smem;
    acc_to_lds<false>(acc, Tl, wr, wc, lane);
    __syncthreads();
#pragma unroll 1
    for (int i0 = 0; i0 < 8; i0 += 4) {
      uint4 zz[4], gg[4]; float bb[4][8];
#pragma unroll
      for (int i = 0; i < 4; ++i) {
        const int id = tid_ + (i0 + i) * 256; const int row = id >> 4, c8 = id & 15;
        const size_t o = (size_t)(rt * 128 + row) * 512 + ct * 128 + c8 * 8;
        zz[i] = *(const uint4*)(Z + o); gg[i] = *(const uint4*)(GS + o);
        ld8f(p.b_glu + ct * 128 + c8 * 8, bb[i]);
      }
#pragma unroll
      for (int i = 0; i < 4; ++i) {
        const int id = tid_ + (i0 + i) * 256; const int row = id >> 4, c8 = id & 15;
        const size_t o = (size_t)(rt * 128 + row) * 512 + ct * 128 + c8 * 8;
        float v[8], z[8], gs[8]; lds_chunk8(Tl, row, c8, v); unpack8(zz[i], z); unpack8(gg[i], gs);
#pragma unroll
        for (int k = 0; k < 8; ++k) v[k] = z[k] * sigmoidf_(v[k] + bb[i][k]) * gs[k];
        *(uint4*)(OS + o) = pack8(v);
      }
    }
    __syncthreads();
  }
}

__device__ __forceinline__ void phase6(const Params& p, char* smem) {
  float* Tl = (float*)smem;
  for (int i = 0;; ++i) {
    int rt, ct; if (!xcd_tile(i, 8, rt, ct)) break;
    const bf16_t* MGA = (const bf16_t*)(p.ws + OFF_MGA); const bf16_t* MGB = (const bf16_t*)(p.ws + OFF_MGB);
    bf16_t* MG = (bf16_t*)(p.ws + OFF_HN);
    AccT acc, acc2; zero_acc(acc); zero_acc(acc2);
    gemm_mainloop_dma2(acc, acc2, (const bf16_t*)(p.ws + OFF_ONSA) + (size_t)rt * 128 * 512, 512, (const bf16_t*)(p.ws + OFF_WAT) + (size_t)ct * 128 * 512, 512,
                       (const bf16_t*)(p.ws + OFF_OS5) + (size_t)rt * 128 * 512, 512, (const bf16_t*)(p.ws + OFF_WBT) + (size_t)ct * 128 * 512, 512, 8, (bf16_t*)smem);
    const int tid_ = otid(); const int lane = tid_ & 63, wid = tid_ >> 6, wr = wid >> 1, wc = wid & 1;
    uint4 hold[8];
    {
      acc_to_lds<false>(acc, Tl, wr, wc, lane);
      __syncthreads();
#pragma unroll
      for (int hb = 0; hb < 2; ++hb) {
        if (hb) asm volatile("" ::: "memory");
        uint4 mg[4];
#pragma unroll
        for (int k = 0; k < 4; ++k) {
          const int id = tid_ + (hb * 4 + k) * 256; const int row = id >> 4, c8 = id & 15;
          mg[k] = *(const uint4*)(MGA + (size_t)(rt * 128 + row) * 1024 + ct * 128 + c8 * 8);
        }
#pragma unroll
        for (int k = 0; k < 4; ++k) {
          const int id = tid_ + (hb * 4 + k) * 256; const int row = id >> 4, c8 = id & 15;
          float v[8], m[8]; lds_chunk8(Tl, row, c8, v); unpack8(mg[k], m);
#pragma unroll
          for (int e = 0; e < 8; ++e) v[e] *= m[e];
          hold[hb * 4 + k] = pack8(v);
        }
      }
      __syncthreads();
    }
    {
      acc_to_lds<false>(acc2, Tl, wr, wc, lane);
      __syncthreads();
#pragma unroll
      for (int hb = 0; hb < 2; ++hb) {
        if (hb) asm volatile("" ::: "memory");
        uint4 mg[4];
#pragma unroll
        for (int k = 0; k < 4; ++k) {
          const int id = tid_ + (hb * 4 + k) * 256; const int row = id >> 4, c8 = id & 15;
          mg[k] = *(const uint4*)(MGB + (size_t)(rt * 128 + row) * 1024 + ct * 128 + c8 * 8);
        }
#pragma unroll
        for (int k = 0; k < 4; ++k) {
          const int id = tid_ + (hb * 4 + k) * 256; const int row = id >> 4, c8 = id & 15;
          float v[8], m[8], hv[8]; lds_chunk8(Tl, row, c8, v); unpack8(mg[k], m); unpack8(hold[hb * 4 + k], hv);
#pragma unroll
          for (int e = 0; e < 8; ++e) v[e] = hv[e] + v[e] * m[e];
          *(uint4*)(MG + (size_t)(rt * 128 + row) * 1024 + ct * 128 + c8 * 8) = pack8(v);
        }
      }
      __syncthreads();
    }
  }
}

__device__ __forceinline__ void phase7(const Params& p, char* smem) {
  const int tid_ = otid(); const int lane = tid_ & 63, wid = tid_ >> 6, wr = wid >> 1, wc = wid & 1;
  float* Tl = (float*)smem;
  for (int i = 0;; ++i) {
    int rt, ct; if (!xcd_tile(i, 8, rt, ct)) break;
    AccT acc; zero_acc(acc);
    gemm_mainloop_dma(acc, (const bf16_t*)(p.ws + OFF_HN) + (size_t)rt * 128 * 1024, 1024, (const bf16_t*)(p.ws + OFF_WOUTT) + (size_t)ct * 128 * 1024, 1024, 16, (bf16_t*)smem);
    float* RSS = (float*)(p.ws + OFF_RSS);
    acc_to_lds<false>(acc, Tl, wr, wc, lane);
    __syncthreads();
#pragma unroll 1
    for (int i0 = 0; i0 < 8; i0 += 4) {
      float xx[4][8];
#pragma unroll
      for (int k = 0; k < 4; ++k) {
        const int id = tid_ + (i0 + k) * 256; const int row = id >> 4, c8 = id & 15;
        ld8f(p.x + (size_t)(rt * 128 + row) * 1024 + ct * 128 + c8 * 8, xx[k]);
      }
#pragma unroll
      for (int k = 0; k < 4; ++k) {
        const int id = tid_ + (i0 + k) * 256; const int row = id >> 4, c8 = id & 15;
        float v[8]; lds_chunk8(Tl, row, c8, v);
        float ss = 0.f;
#pragma unroll
        for (int e = 0; e < 8; ++e) { v[e] += xx[k][e]; ss += v[e] * v[e]; }
        st8f(p.out + (size_t)(rt * 128 + row) * 1024 + ct * 128 + c8 * 8, v);
        ss += __shfl_xor(ss, 1); ss += __shfl_xor(ss, 2); ss += __shfl_xor(ss, 4); ss += __shfl_xor(ss, 8);
        if (c8 == 0) RSS[(size_t)(rt * 128 + row) * 16 + ct] = ss;
      }
    }
    __syncthreads();
  }
}

__device__ __forceinline__ void phase8(const Params& p) {
  const int tid_ = otid(); const int lane = tid_ & 63, wid = tid_ >> 6;
  for (int u = blockIdx.x; u < 1024; u += gridDim.x) {
    const size_t row0 = (size_t)u * 16 + wid * 4;
    float4 v[4][4]; float sc[4];
#pragma unroll
    for (int r = 0; r < 4; ++r) {
      const float4* o = (const float4*)(p.out + (row0 + r) * DM);
#pragma unroll
      for (int i = 0; i < 4; ++i) v[r][i] = o[lane + i * 64];
    }
    float4 g[4];
#pragma unroll
    for (int i = 0; i < 4; ++i) g[i] = ((const float4*)p.final_g)[lane + i * 64];
#pragma unroll
    for (int r = 0; r < 4; ++r) {
      const float4* rs = (const float4*)((const float*)(p.ws + OFF_RSS) + (row0 + r) * 16);
      const float4 a = rs[0], b = rs[1];
      const float ss = ((a.x + a.y) + (a.z + a.w)) + ((b.x + b.y) + (b.z + b.w));
      sc[r] = rsqrtf(ss * (1.0f / DM) + 1.0e-6f);
    }
#pragma unroll
    for (int r = 0; r < 4; ++r) {
      float4* o = (float4*)(p.out + (row0 + r) * DM);
#pragma unroll
      for (int i = 0; i < 4; ++i) {
        float4 w = v[r][i];
        w.x *= sc[r] * g[i].x; w.y *= sc[r] * g[i].y; w.z *= sc[r] * g[i].z; w.w *= sc[r] * g[i].w;
        o[lane + i * 64] = w;
      }
    }
  }
}

#define XB_TMO      128
#define XB_XCNT(j)  (256  + 64 * (j))
#define XB_XSUB(j)  (1280 + 64 * (j))
#define XB_XGEN(j)  (2304 + 64 * (j))
#define XB_TOP      3328
#define XB_TOPGEN   3392
#define XCD_BAR_WORDS 3456
#define XB_SPIN_CAP (1u << 18)
#define LAS __attribute__((address_space(3)))
__device__ __forceinline__ unsigned xb_ld(unsigned* p)              { return __hip_atomic_load(p, __ATOMIC_RELAXED, __HIP_MEMORY_SCOPE_AGENT); }
__device__ __forceinline__ unsigned xb_add(unsigned* p, unsigned v) { return __hip_atomic_fetch_add(p, v, __ATOMIC_RELAXED, __HIP_MEMORY_SCOPE_AGENT); }
__device__ __forceinline__ unsigned xb_xcc_id() { return (unsigned)__builtin_amdgcn_s_getreg((3 << 11) | 20) & 0xFu; }
#define XB_SPIN(cond, bar) do { unsigned _sp = 0; while (cond) { __builtin_amdgcn_s_sleep(1); \
    if ((++_sp & 255u) == 0u) { if (xb_ld(&(bar)[XB_TMO])) break; if (_sp > XB_SPIN_CAP) { atomicAdd(&(bar)[XB_TMO], 1u); break; } } } } while (0)
struct XcdBarrier { unsigned* bar; unsigned x; volatile LAS unsigned* st; };
__device__ __forceinline__ XcdBarrier xcd_barrier_post(unsigned* bar, volatile LAS unsigned* st) {
    XcdBarrier b; b.bar = bar; b.x = xb_xcc_id(); b.st = st;
    if (threadIdx.x == 0) (void)xb_add(&bar[XB_XCNT(b.x)], 1u);
    return b;
}
__device__ __forceinline__ void xcd_barrier_complete(unsigned* bar, unsigned x, unsigned& nloc, unsigned& nx) {
    const unsigned G = gridDim.x * gridDim.y * gridDim.z;
    unsigned sum, cnt, mine, sp = 0u;
    for (;;) {
        sum = 0u; cnt = 0u; mine = 0u;
#pragma unroll
        for (unsigned j = 0; j < 16; ++j) { const unsigned c = xb_ld(&bar[XB_XCNT(j)]); sum += c; cnt += (c > 0u) ? 1u : 0u; mine = (j == x) ? c : mine; }
        if (sum == G) break;
        __builtin_amdgcn_s_sleep(1);
        if ((++sp & 255u) == 0u) { if (xb_ld(&bar[XB_TMO])) break; if (sp > XB_SPIN_CAP) { atomicAdd(&bar[XB_TMO], 1u); break; } }
    }
    nloc = mine > 0u ? mine : 1u; nx = cnt > 0u ? cnt : 1u;
}
__device__ __forceinline__ void xcd_barrier(unsigned* bar, unsigned x, volatile LAS unsigned* st) {
    asm volatile("s_waitcnt vmcnt(0)" ::: "memory");
    __syncthreads();
    if (threadIdx.x == 0) {
        __builtin_amdgcn_s_waitcnt(0);
        unsigned nloc = st[0], nx = st[1];
        if (nloc == 0u) { xcd_barrier_complete(bar, x, nloc, nx); st[0] = nloc; st[1] = nx; }
        const unsigned old = xb_add(&bar[XB_XSUB(x)], 1u);
        const unsigned gen = old / nloc;
        if (old + 1u == (gen + 1u) * nloc) {
            __builtin_amdgcn_fence(__ATOMIC_RELEASE, "agent");
            asm volatile("s_waitcnt vmcnt(0)" ::: "memory");
            const unsigned og = xb_add(&bar[XB_TOP], 1u);
            const unsigned tg = og / nx;
            if (og + 1u == (tg + 1u) * nx) xb_add(&bar[XB_TOPGEN], 1u);
            else XB_SPIN(xb_ld(&bar[XB_TOPGEN]) == tg, bar);
            __builtin_amdgcn_fence(__ATOMIC_ACQUIRE, "agent");
            xb_add(&bar[XB_XGEN(x)], 1u);
            asm volatile("s_waitcnt vmcnt(0)" ::: "memory");
        } else {
            XB_SPIN(xb_ld(&bar[XB_XGEN(x)]) == gen, bar);
            __builtin_amdgcn_fence(__ATOMIC_ACQUIRE, "agent");
            asm volatile("s_waitcnt vmcnt(0)" ::: "memory");
        }
    }
    __syncthreads();
}

constexpr int SMEM_BYTES = NSA_SMEM_BYTES > GEMM_SMEM_BYTES ? NSA_SMEM_BYTES : GEMM_SMEM_BYTES;

template <int PH>
__global__ void __launch_bounds__(NTHR, 2) k_phase(Params p) {
  __shared__ __attribute__((aligned(16))) char smem[SMEM_BYTES];
  if (PH == 0) phase0(p, smem);
  if (PH == 1) phase1(p, smem);
  if (PH == 2) phase2(p, smem);
  if (PH == 3) phase3(p, smem);
  if (PH == 4) phase4(p, smem);
  if (PH == 5) phase5(p, smem);
  if (PH == 6) phase6(p, smem);
  if (PH == 7) phase7(p, smem);
  if (PH == 8) phase8(p);
}

__device__ __forceinline__ Params fresh(const Params& p) { Params q = p; asm volatile("" : "+s"(q.ws), "+s"(q.out)); return q; }
#if !MULTI_LAUNCH
#define GSYNC() xcd_barrier(bar, xb.x, xb.st)
__global__ void __launch_bounds__(NTHR, 2) k_mega(Params p) {
  __shared__ __attribute__((aligned(16))) char smem[SMEM_BYTES];
  __shared__ uint4 xb_words;
  unsigned* bar = (unsigned*)(p.ws + OFF_BAR);
  if (threadIdx.x == 0) xb_words = make_uint4(0u, 0u, 0u, 0u);
  __syncthreads();
  XcdBarrier xb = xcd_barrier_post(bar, (volatile LAS unsigned*)&xb_words);
  if (threadIdx.x == 0) xinfo_s[2] = (int)xb_add(&bar[XCD_BAR_WORDS + 64 * xb.x], 1u);
  if (p.ws == nullptr) cg::this_grid().sync();
  { int reps = 1 + (PROBE_DUP == 0 ? 1 : 0); asm volatile("" : "+s"(reps)); for (int r = 0; r < reps; ++r) { const Params q = fresh(p); phase0(q, smem); GSYNC(); } }
  if (threadIdx.x == 0) {
    int nx = 0, xi = 0, nloc = 1;
    for (unsigned j = 0; j < 16; ++j) {
      const int c = (int)xb_ld(&bar[XCD_BAR_WORDS + 64 * j]);
      nx += (c > 0) ? 1 : 0; xi += (c > 0 && j < xb.x) ? 1 : 0; if (j == xb.x) nloc = c > 0 ? c : 1;
    }
    xinfo_s[0] = xi; xinfo_s[1] = nx > 0 ? nx : 1; xinfo_s[3] = nloc;
  }
  __syncthreads();
  { int reps = 1 + (PROBE_DUP == 1 ? 1 : 0); asm volatile("" : "+s"(reps)); for (int r = 0; r < reps; ++r) { const Params q = fresh(p); phase1(q, smem); GSYNC(); } }
  { int reps = 1 + (PROBE_DUP == 2 ? 1 : 0); asm volatile("" : "+s"(reps)); for (int r = 0; r < reps; ++r) { const Params q = fresh(p); phase2(q, smem); GSYNC(); } }
  { int reps = 1 + (PROBE_DUP == 3 ? 1 : 0); asm volatile("" : "+s"(reps)); for (int r = 0; r < reps; ++r) { const Params q = fresh(p); phase3(q, smem); GSYNC(); } }
  { int reps = 1 + (PROBE_DUP == 4 ? 1 : 0); asm volatile("" : "+s"(reps)); for (int r = 0; r < reps; ++r) { const Params q = fresh(p); phase4(q, smem); GSYNC(); } }
  { int reps = 1 + (PROBE_DUP == 5 ? 1 : 0); asm volatile("" : "+s"(reps)); for (int r = 0; r < reps; ++r) { const Params q = fresh(p); phase5(q, smem); GSYNC(); } }
  { int reps = 1 + (PROBE_DUP == 6 ? 1 : 0); asm volatile("" : "+s"(reps)); for (int r = 0; r < reps; ++r) { const Params q = fresh(p); phase6(q, smem); GSYNC(); } }
  { int reps = 1 + (PROBE_DUP == 7 ? 1 : 0); asm volatile("" : "+s"(reps)); for (int r = 0; r < reps; ++r) { const Params q = fresh(p); phase7(q, smem); GSYNC(); } }
  { const Params q = fresh(p); phase8(q); }
}
#endif

extern "C" void kernel_launch(void* const* d_in, const int* in_sizes, int n_in, void* d_out, int out_size, void* d_ws, size_t ws_size,
                              hipStream_t stream) {
  Params p{};
  const float** f = (const float**)&p;
  for (int i = 0; i < 23; ++i) f[i] = (const float*)d_in[i];
  p.out = (float*)d_out;
  p.ws = (char*)d_ws;
#if MULTI_LAUNCH
  const int G = 1024;
  k_phase<0><<<G, NTHR, 0, stream>>>(p);
  k_phase<1><<<G, NTHR, 0, stream>>>(p);
  k_phase<2><<<G, NTHR, 0, stream>>>(p);
  k_phase<3><<<G, NTHR, 0, stream>>>(p);
  k_phase<4><<<G, NTHR, 0, stream>>>(p);
  k_phase<5><<<G, NTHR, 0, stream>>>(p);
  k_phase<6><<<G, NTHR, 0, stream>>>(p);
  k_phase<7><<<G, NTHR, 0, stream>>>(p);
  k_phase<8><<<G, NTHR, 0, stream>>>(p);
#else
  static int grid_blocks = 0;
  if (!grid_blocks) {
    int dev = 0, cus = 0, per_cu = 0;
    hipGetDevice(&dev);
    hipDeviceGetAttribute(&cus, hipDeviceAttributeMultiprocessorCount, dev);
    hipOccupancyMaxActiveBlocksPerMultiprocessor(&per_cu, k_mega, NTHR, 0);
    if (per_cu > 2) per_cu = 2;
    grid_blocks = cus * per_cu;
  }
  (void)hipMemsetAsync((char*)d_ws + OFF_BAR, 0, (XCD_BAR_WORDS + 1024 + 16 + 18 * 16) * sizeof(unsigned), stream);
  void* args[] = {&p};
  hipError_t e = hipLaunchCooperativeKernel((void*)k_mega, dim3(grid_blocks), dim3(NTHR), args, 0, stream);
  if (e != hipSuccess) fprintf(stderr, "cooperative launch failed: %s (grid %d)\n", hipGetErrorString(e), grid_blocks);
#endif
}
```
